# Optimizing an MI355X kernel written in HIP

```python
import jax, jax.numpy as jnp
from jax import lax
import numpy as np

D_MODEL = 2048
BATCH = 4
SEQ = 2048
DEPTH = 2

CTX_LEN = 256
GRID_W = 64
POOL_WINDOWS = (2, 4, 8, 16)
POOL_GROUP = D_MODEL // 8
POOL_WIDTH = POOL_GROUP * len(POOL_WINDOWS)
CONV_WIDTH = D_MODEL // 2
N_HEADS = 16
QK_NOPE = 128
QK_ROPE = 64
ROPE_AXIS = QK_ROPE // 2
V_DIM = 128
QK_DIM = QK_NOPE + QK_ROPE
Q_LORA = 512
KV_LORA = 512
ROPE_THETA = 10000.0
ATTN_SCALE = QK_DIM ** -0.5
Q_BLOCK = 128
D_FF = 5632
N_BRANCH = 3
EPS = 1e-6
OFF_A = 0
OFF_B = OFF_A + POOL_WIDTH
OFF_Q = OFF_B + 3 * CONV_WIDTH
OFF_KV = OFF_Q + Q_LORA
OFF_G = OFF_KV + KV_LORA + QK_ROPE
IN_COLS = OFF_G + N_BRANCH * D_MODEL

kernel_name = 'hybrid_pool_conv_mla_prefix_dit_block'


def rmsnorm(x, g):
    xf = x.astype(jnp.float32)
    y = xf * lax.rsqrt(jnp.mean(xf * xf, axis=-1, keepdims=True) + EPS)
    return (y * g.astype(jnp.float32)).astype(x.dtype)


def modulate(x, g, shift, scale):
    return rmsnorm(x, g) * (1 + scale) + shift


def conv3_centred(z, w):
    zp = jnp.pad(z, ((0, 0), (1, 1), (0, 0)))
    return zp[:, :-2] * w[0] + zp[:, 1:-1] * w[1] + zp[:, 2:] * w[2]


def multiscale_pool(a, pool_w, pool_scale):
    Bn, L, _ = a.shape
    af = a.astype(jnp.float32)
    prefix = jnp.concatenate([jnp.zeros((Bn, 1, POOL_WIDTH), jnp.float32), jnp.cumsum(af, axis=1)], axis=1)
    t = jnp.arange(L)
    outs = []
    for gi, w in enumerate(POOL_WINDOWS):
        lo = jnp.clip(t - w // 2, 0, L)
        hi = jnp.clip(t + w // 2, 0, L)
        sl = slice(gi * POOL_GROUP, (gi + 1) * POOL_GROUP)
        pg = prefix[:, :, sl]
        cnt = (hi - lo).astype(jnp.float32)[None, :, None]
        outs.append((pg[:, hi] - pg[:, lo]) / cnt - af[:, :, sl])
    pooled = jnp.stack(outs, axis=2).astype(a.dtype)
    mixed = jnp.einsum('blgc,gcd->blgd', pooled, pool_w)
    return mixed.reshape(Bn, L, POOL_WIDTH) * pool_scale


def axial_rope_tables(length):
    rows = length // GRID_W
    row = jnp.repeat(jnp.arange(rows, dtype=jnp.int32), GRID_W).astype(jnp.float32)
    col = jnp.tile(jnp.arange(GRID_W, dtype=jnp.int32), rows).astype(jnp.float32)
    inv = ROPE_THETA ** (-jnp.arange(0, ROPE_AXIS, 2, dtype=jnp.float32) / ROPE_AXIS)
    ang_r = row[:, None] * inv[None]
    ang_c = col[:, None] * inv[None]
    return (jnp.cos(ang_r), jnp.sin(ang_r), jnp.cos(ang_c), jnp.sin(ang_c))


def rotate_half(x, cos, sin):
    x1, x2 = jnp.split(x, 2, axis=-1)
    return jnp.concatenate([x1 * cos - x2 * sin, x1 * sin + x2 * cos], axis=-1)


def apply_axial_rope(x, tables):
    cr, sr, cc, sc = tables
    xf = x.astype(jnp.float32)
    out = jnp.concatenate([rotate_half(xf[..., :ROPE_AXIS], cr, sr),
                           rotate_half(xf[..., ROPE_AXIS:], cc, sc)], axis=-1)
    return out.astype(x.dtype)


def mla_q(zq, q_lora_g, w_uq, q_head_g, rope):
    cq = rmsnorm(zq, q_lora_g)
    q = rmsnorm(jnp.einsum('blr,rhd->bhld', cq, w_uq), q_head_g)
    if rope is not None:
        q = jnp.concatenate([q[..., :QK_NOPE], apply_axial_rope(q[..., QK_NOPE:], rope)], axis=-1)
    return q


def mla_kv(zkv, kv_lora_g, w_ukv, k_head_g, rope):
    ckv = rmsnorm(zkv[..., :KV_LORA], kv_lora_g)
    k_rope = zkv[..., KV_LORA:]
    kv = jnp.einsum('blr,rhd->bhld', ckv, w_ukv)
    k_nope, v = kv[..., :QK_NOPE], kv[..., QK_NOPE:]
    Bn, H, L, _ = k_nope.shape
    k = jnp.concatenate([k_nope, jnp.broadcast_to(k_rope[:, None], (Bn, H, L, QK_ROPE))], axis=-1)
    k = rmsnorm(k, k_head_g)
    if rope is not None:
        k = jnp.concatenate([k[..., :QK_NOPE], apply_axial_rope(k[..., QK_NOPE:], rope)], axis=-1)
    return k, v


def attend(q, k, v):
    s = jnp.einsum('bhqd,bhkd->bhqk', q, k).astype(jnp.float32) * ATTN_SCALE
    p = jax.nn.softmax(s, axis=-1).astype(v.dtype)
    return jnp.einsum('bhqk,bhkd->bhqd', p, v)


def blocked_attend(q, k, v):
    Bn, H, L, Dq = q.shape
    nb = L // Q_BLOCK
    qb = q.reshape(Bn, H, nb, Q_BLOCK, Dq).transpose(2, 0, 1, 3, 4)
    ob = lax.map(lambda qi: attend(qi, k, v), qb)
    return ob.transpose(1, 2, 0, 3, 4).reshape(Bn, H, L, V_DIM)


def token_mixers(h, lp, rope, ctx_kv):
    Bn, L, _ = h.shape
    z = h @ lp['w_in']
    y_a = multiscale_pool(z[..., OFF_A:OFF_B], lp['pool_w'], lp['pool_scale']) @ lp['w_branch_a']
    gate_b, gate_c, xin = jnp.split(z[..., OFF_B:OFF_Q], 3, axis=-1)
    y_b = (gate_b * conv3_centred(gate_c * xin, lp['conv_w'])) @ lp['w_branch_b']
    q = mla_q(z[..., OFF_Q:OFF_KV], lp['q_lora_g'], lp['w_uq'], lp['q_head_g'], rope)
    k, v = mla_kv(z[..., OFF_KV:OFF_G], lp['kv_lora_g'], lp['w_ukv'], lp['k_head_g'], rope)
    if ctx_kv is None:
        o = attend(q, k, v)
    else:
        k_ctx, v_ctx = ctx_kv
        o = blocked_attend(q, jnp.concatenate([k, k_ctx], axis=2), jnp.concatenate([v, v_ctx], axis=2))
    y_c = o.transpose(0, 2, 1, 3).reshape(Bn, L, N_HEADS * V_DIM) @ lp['w_branch_c']
    g = jax.nn.sigmoid(z[..., OFF_G:].astype(jnp.float32)).astype(h.dtype).reshape(Bn, L, N_BRANCH, D_MODEL)
    merged = g[..., 0, :] * y_a + g[..., 1, :] * y_b + g[..., 2, :] * y_c
    return merged @ lp['w_out'], (k, v)


def conv_ffn(h, w_up, conv, w_down):
    u, v = jnp.split(h @ w_up, 2, axis=-1)
    return (jax.nn.silu(conv3_centred(u, conv)) * v) @ w_down


def setup_inputs(seed: int = 0) -> dict:
    key = jax.random.key(seed)
    ks = jax.random.split(key, 32)
    f32 = jnp.float32

    def nrm(k, shape, scale):
        return jax.random.normal(k, shape, f32) * scale

    def gain(k, shape):
        return 1.0 + 0.05 * jax.random.normal(k, shape, f32)

    Dp = DEPTH
    return {
        'x': nrm(ks[0], (BATCH, SEQ, D_MODEL), 1.0),
        'c': nrm(ks[1], (BATCH, D_MODEL), 1.0),
        'ctx': nrm(ks[2], (BATCH, CTX_LEN, D_MODEL), 1.0),
        'c_ctx': nrm(ks[3], (D_MODEL,), 1.0),
        'norm1_g': gain(ks[4], (Dp, D_MODEL)),
        'norm2_g': gain(ks[5], (Dp, D_MODEL)),
        'w_mod': nrm(ks[6], (Dp, D_MODEL, 6 * D_MODEL), 0.5 * D_MODEL ** -0.5),
        'b_mod': nrm(ks[7], (Dp, 6 * D_MODEL), 0.01),
        'w_in': nrm(ks[8], (Dp, D_MODEL, IN_COLS), D_MODEL ** -0.5),
        'pool_w': nrm(ks[9], (Dp, len(POOL_WINDOWS), POOL_GROUP, POOL_GROUP), POOL_GROUP ** -0.5),
        'pool_scale': gain(ks[10], (Dp, POOL_WIDTH)),
        'conv_w': nrm(ks[11], (Dp, 3, CONV_WIDTH), 3 ** -0.5),
        'q_lora_g': gain(ks[12], (Dp, Q_LORA)),
        'w_uq': nrm(ks[13], (Dp, Q_LORA, N_HEADS, QK_DIM), Q_LORA ** -0.5),
        'kv_lora_g': gain(ks[14], (Dp, KV_LORA)),
        'w_ukv': nrm(ks[15], (Dp, KV_LORA, N_HEADS, QK_NOPE + V_DIM), KV_LORA ** -0.5),
        'q_head_g': gain(ks[16], (Dp, QK_DIM)),
        'k_head_g': gain(ks[17], (Dp, QK_DIM)),
        'w_branch_a': nrm(ks[18], (Dp, POOL_WIDTH, D_MODEL), POOL_WIDTH ** -0.5),
        'w_branch_b': nrm(ks[19], (Dp, CONV_WIDTH, D_MODEL), CONV_WIDTH ** -0.5),
        'w_branch_c': nrm(ks[20], (Dp, N_HEADS * V_DIM, D_MODEL), (N_HEADS * V_DIM) ** -0.5),
        'w_out': nrm(ks[21], (Dp, D_MODEL, D_MODEL), D_MODEL ** -0.5),
        'w_ffn_up': nrm(ks[22], (Dp, D_MODEL, 2 * D_FF), D_MODEL ** -0.5),
        'ffn_conv': nrm(ks[23], (Dp, 3, D_FF), 3 ** -0.5),
        'w_ffn_down': nrm(ks[24], (Dp, D_FF, D_MODEL), D_FF ** -0.5),
    }


def reference(x, c, ctx, c_ctx, norm1_g, norm2_g, w_mod, b_mod, w_in, pool_w, pool_scale, conv_w,
              q_lora_g, w_uq, kv_lora_g, w_ukv, q_head_g, k_head_g, w_branch_a, w_branch_b,
              w_branch_c, w_out, w_ffn_up, ffn_conv, w_ffn_down):
    rope = axial_rope_tables(x.shape[1])
    for i in range(DEPTH):
        last = i == DEPTH - 1
        lp = dict(w_in=w_in[i], pool_w=pool_w[i], pool_scale=pool_scale[i], conv_w=conv_w[i],
                  q_lora_g=q_lora_g[i], w_uq=w_uq[i], kv_lora_g=kv_lora_g[i], w_ukv=w_ukv[i],
                  q_head_g=q_head_g[i], k_head_g=k_head_g[i], w_branch_a=w_branch_a[i],
                  w_branch_b=w_branch_b[i], w_branch_c=w_branch_c[i], w_out=w_out[i])
        mod_x = jnp.split((jax.nn.silu(c) @ w_mod[i] + b_mod[i])[:, None, :], 6, axis=-1)
        mod_c = jnp.split(jax.nn.silu(c_ctx) @ w_mod[i] + b_mod[i], 6, axis=-1)
        sh1x, sc1x, g1x, sh2x, sc2x, g2x = mod_x
        sh1c, sc1c, g1c, sh2c, sc2c, g2c = mod_c
        hc = modulate(ctx, norm1_g[i], sh1c, sc1c)
        if last:
            k_c, v_c = mla_kv(hc @ lp['w_in'][:, OFF_KV:OFF_G], lp['kv_lora_g'], lp['w_ukv'],
                              lp['k_head_g'], None)
        else:
            ctx_mix, (k_c, v_c) = token_mixers(hc, lp, None, None)
            ctx = ctx + g1c * ctx_mix
            ctx = ctx + g2c * conv_ffn(modulate(ctx, norm2_g[i], sh2c, sc2c), w_ffn_up[i], ffn_conv[i], w_ffn_down[i])
        hx = modulate(x, norm1_g[i], sh1x, sc1x)
        x_mix, _ = token_mixers(hx, lp, rope, (k_c, v_c))
        x = x + g1x * x_mix
        x = x + g2x * conv_ffn(modulate(x, norm2_g[i], sh2x, sc2x), w_ffn_up[i], ffn_conv[i], w_ffn_down[i])
    return x
```

```cpp
#include <hip/hip_runtime.h>
#include <hip/hip_cooperative_groups.h>
#include <cstdio>
#include <cstdint>
namespace cg = cooperative_groups;

#define LAS __attribute__((address_space(3)))
typedef unsigned short bf16_t;
typedef short bf16x8 __attribute__((ext_vector_type(8)));
typedef short s16x4 __attribute__((ext_vector_type(4)));
typedef float f32x4 __attribute__((ext_vector_type(4)));
typedef float f32x16 __attribute__((ext_vector_type(16)));
typedef unsigned u32x4 __attribute__((ext_vector_type(4)));
typedef unsigned u32x2 __attribute__((ext_vector_type(2)));

constexpr int DM = 2048, NBATCH = 4, SEQ = 2048, CTXL = 256, NH = 16;
constexpr int ML = NBATCH * SEQ, MC = NBATCH * CTXL, MT = ML + MC;
constexpr int IN_COLS = 11328, OFF_G = 5184;
constexpr int Z1C = 5376, GC = 6144, ZP = Z1C + GC;
constexpr int DFF = 5632, SKV = SEQ + CTXL;
constexpr int MODW = 6 * DM;
constexpr float EPS = 1e-6f;

constexpr size_t al256(size_t x) { return (x + 255) / 256 * 256; }
constexpr size_t WS_WIN = 0;
constexpr size_t WS_WPOOL = WS_WIN + (size_t)ZP * DM * 2;
constexpr size_t WS_WUQ = WS_WPOOL + (size_t)1024 * 256 * 2;
constexpr size_t WS_WUKV = WS_WUQ + (size_t)4096 * 512 * 2;
constexpr size_t WS_WBA = WS_WUKV + (size_t)4096 * 512 * 2;
constexpr size_t WS_WBB = WS_WBA + (size_t)2048 * 1024 * 2;
constexpr size_t WS_WBC = WS_WBB + (size_t)2048 * 1024 * 2;
constexpr size_t WS_WOUT = WS_WBC + (size_t)2048 * 2048 * 2;
constexpr size_t WS_WUP = WS_WOUT + (size_t)2048 * 2048 * 2;
constexpr size_t WS_WDN = WS_WUP + (size_t)2 * DFF * DM * 2;
constexpr size_t WSET = WS_WDN + (size_t)DM * DFF * 2;
constexpr size_t WS_MOD = 2 * WSET;
constexpr size_t WS_H = WS_MOD + al256((size_t)2 * 5 * MODW * 4);
constexpr size_t WS_Z1 = WS_H + (size_t)MT * DM * 2;
constexpr size_t WS_G = WS_Z1 + (size_t)MT * Z1C * 2;
constexpr size_t WS_PCK = WS_G + (size_t)MT * GC * 2;
constexpr size_t WS_U = WS_PCK + (size_t)MT * 2048 * 2;
constexpr size_t WS_MA = WS_U + (size_t)MT * 1024 * 2;
constexpr size_t WS_QK = WS_MA + (size_t)MT * 1024 * 2;
constexpr size_t WS_VN = WS_QK + (size_t)2 * 64 * SKV * 192 * 2;
constexpr size_t WS_KR = WS_VN + (size_t)64 * SKV * 128 * 2;
constexpr size_t WS_XC = WS_KR + (size_t)MT * 64 * 2;
constexpr size_t WS_PART = WS_XC + (size_t)MC * DM * 4;
constexpr size_t WS_SIDE = WS_PART + (size_t)8 * MC * DM * 4;
constexpr size_t WS_KRSS = WS_SIDE + (size_t)36 * 6 * DFF * 4;
constexpr size_t WS_BAR = WS_KRSS + al256((size_t)MT * 4);
constexpr size_t BAR_BYTES = 16384;
constexpr size_t WS_END = WS_BAR + BAR_BYTES;
static_assert((size_t)MT * 2 * DFF * 2 <= (size_t)MT * ZP * 2, "UV fits Z");
static_assert((size_t)MT * DFF * 2 <= (size_t)2 * 64 * SKV * 192 * 2, "F fits QK");
static_assert((size_t)MT * DM * 4 <= (size_t)2 * 64 * SKV * 192 * 2, "TMP fits QK");

static_assert(WS_END <= (size_t)871717888, "workspace must fit the guaranteed size (sum of the inputs)");
constexpr int LDS_STAGE = 131072;
constexpr int LDS_EDGE = LDS_STAGE + 256;
constexpr int LDS_BYTES = LDS_EDGE + 4096;

__device__ __forceinline__ int lane_id_() { int l; asm volatile("v_mbcnt_lo_u32_b32 %0, -1, 0\n\tv_mbcnt_hi_u32_b32 %0, -1, %0" : "=v"(l)); return l; }
__device__ __forceinline__ float shx(float v, int m) { return __int_as_float(__builtin_amdgcn_ds_bpermute((lane_id_() ^ m) << 2, __float_as_int(v))); }
#define TID_() (cx_wave * 64 + lane_id_())
__device__ __forceinline__ unsigned cvt_pk_bf16(float lo, float hi) { unsigned r; asm volatile("v_cvt_pk_bf16_f32 %0, %1, %2" : "=v"(r) : "v"(lo), "v"(hi)); return r; }
__device__ __forceinline__ float bf_lo(unsigned w) { return __uint_as_float(w << 16); }
__device__ __forceinline__ float bf_hi(unsigned w) { return __uint_as_float(w & 0xffff0000u); }
__device__ __forceinline__ float bf2f(bf16_t b) { return __uint_as_float(((unsigned)b) << 16); }
__device__ __forceinline__ bf16_t f2bf(float f) { unsigned u = __float_as_uint(f); return (bf16_t)((u + 0x7fffu + ((u >> 16) & 1u)) >> 16); }
__device__ __forceinline__ float wave_sum(float v) {
#pragma unroll
    for (int o = 1; o < 64; o <<= 1) v += shx(v, o);
    return v;
}
__device__ __forceinline__ void unpack8(u32x4 w, float* f) {
    f[0] = bf_lo(w.x); f[1] = bf_hi(w.x); f[2] = bf_lo(w.y); f[3] = bf_hi(w.y); f[4] = bf_lo(w.z); f[5] = bf_hi(w.z); f[6] = bf_lo(w.w); f[7] = bf_hi(w.w);
}
__device__ __forceinline__ u32x4 pack8(const float* f) {
    u32x4 w; w.x = cvt_pk_bf16(f[0], f[1]); w.y = cvt_pk_bf16(f[2], f[3]); w.z = cvt_pk_bf16(f[4], f[5]); w.w = cvt_pk_bf16(f[6], f[7]); return w;
}
__device__ __forceinline__ float sigmoidf_(float x) { return __builtin_amdgcn_rcpf(1.f + __builtin_amdgcn_exp2f(-1.4426950408889634f * x)); }

namespace pg8 {
constexpr int BM = 256, BK = 64, HALF = 128, HTB = HALF * BK * 2, STAGE_BYTES = 8 * HTB, NXCD = 8, WGM = 8;
__host__ __device__ __forceinline__ int lds_byte(int r, int c) { const int st = (r >> 4) * 2 + (c >> 5), rr = r & 15, cc = c & 31, ob = rr * 64 + cc * 2; return st * 1024 + (ob ^ (((ob >> 9) & 1) << 5)); }
__host__ __device__ __forceinline__ void stage_rc(int b, int& R, int& C) { const int st = b / 1024, sb = b % 1024, swz = sb ^ (((sb >> 9) & 1) << 5); R = (st >> 1) * 16 + swz / 64; C = (st & 1) * 32 + (swz % 64) / 2; }
__host__ __device__ __forceinline__ int perm32(int rho) { const int n = rho >> 4, i = rho & 15; return 8 * (i >> 2) + 4 * n + (i & 3); }

struct UnitD { const char* A; const char* B; int lda, ldb, nt, pm, pn, job, keep; };

__device__ __forceinline__ void map_tile(int wgid, int nM, int nN, int& pm, int& pn) {
    const int nwg = nM * nN;
    { const int q = nwg / NXCD, r = nwg % NXCD, xcd = wgid % NXCD, off = wgid / NXCD; wgid = (xcd < r ? xcd * (q + 1) : r * (q + 1) + (xcd - r) * q) + off; }
    const int nig = WGM * nN, gid = wgid / nig, fm = gid * WGM, gsz = (nM - fm) < WGM ? (nM - fm) : WGM;
    pm = fm + ((wgid % nig) % gsz); pn = (wgid % nig) / gsz;
}

template <class Sched, class Epi>
__device__ __forceinline__ void gemm_stream(LAS unsigned char* lds, const Sched& S, const Epi& E, const int cx_wave) {
    int tid_l = TID_(); asm volatile("" : "+v"(tid_l));
    const int tid = tid_l, wid = __builtin_amdgcn_readfirstlane(tid >> 6), lane = tid & 63, wr = wid >> 2, wc = wid & 3, fr = lane & 15, fq = lane >> 4;
    int R0, C0; stage_rc(tid * 16, R0, C0);
    const int Rb0 = (R0 & ~31) + perm32(R0 & 31);
    const size_t kstep = (size_t)(BK * 2);
    const unsigned ldsw = (unsigned)wid * 1024u;
    const int aoff = lds_byte(wr * 64 + fr, fq * 8), boff = lds_byte(wc * 32 + fr, fq * 8);
#define PG8_SA(b, h) (((b) * 2 + (h)) * HTB)
#define PG8_SB(b, h) ((4 + (b) * 2 + (h)) * HTB)
#define PG8_STAGE(bufoff, gbase, voff, h64) do { _Pragma("unroll") for (int _i = 0; _i < 2; ++_i) \
        __builtin_amdgcn_global_load_lds((const unsigned*)((const char*)(gbase) + (_i ? (h64) : (size_t)0) + (voff)), (LAS unsigned*)(lds + (bufoff) + ldsw + _i * 8192), 16, 0, 0); } while (0)
#define PG8_LDA(dst, b, h) do { _Pragma("unroll") for (int m = 0; m < 4; ++m) _Pragma("unroll") for (int k = 0; k < 2; ++k) dst[m][k] = *(const LAS bf16x8*)(lds + PG8_SA(b, h) + aoff + m * 2048 + k * 1024); } while (0)
#define PG8_LDB(dst, b, h) do { _Pragma("unroll") for (int n = 0; n < 2; ++n) _Pragma("unroll") for (int k = 0; k < 2; ++k) dst[n][k] = *(const LAS bf16x8*)(lds + PG8_SB(b, h) + boff + n * 2048 + k * 1024); } while (0)
#define PG8_MMA(ai, bj, At, Bt) do { __builtin_amdgcn_s_setprio(1); _Pragma("unroll") for (int m = 0; m < 4; ++m) _Pragma("unroll") for (int n = 0; n < 2; ++n) _Pragma("unroll") for (int k = 0; k < 2; ++k) \
        acc[ai][bj][m][n] = __builtin_amdgcn_mfma_f32_16x16x32_bf16(Bt[n][k], At[m][k], acc[ai][bj][m][n], 0, 0, 0); __builtin_amdgcn_s_setprio(0); } while (0)
#define PG8_WAIT_V(n) asm volatile("s_waitcnt vmcnt(" #n ")" ::: "memory")
#define PG8_WAIT_L(n) asm volatile("s_waitcnt lgkmcnt(" #n ")" ::: "memory")
#define PG8_BAR __builtin_amdgcn_s_barrier()
#define PG8_SCHED __builtin_amdgcn_sched_barrier(0)
#define PG8_VA(ld) ((unsigned)(R0 * (ld) + C0) * 2u)
#define PG8_VB(ld) ((unsigned)(Rb0 * (ld) + C0) * 2u)
    UnitD cur, nxt; int ui = 0;
    if (!S.next(0, cur)) return;
    f32x4 acc[2][2][4][2];
#pragma unroll
    for (int a = 0; a < 2; ++a)
#pragma unroll
        for (int b = 0; b < 2; ++b)
#pragma unroll
            for (int m = 0; m < 4; ++m)
#pragma unroll
                for (int n = 0; n < 2; ++n) acc[a][b][m][n] = (f32x4){0.f, 0.f, 0.f, 0.f};
    bf16x8 At[4][2], B0[2][2], B1[2][2];
    const char* cA = cur.A; const char* cB = cur.B;
    { const unsigned vAc = PG8_VA(cur.lda), vBc = PG8_VB(cur.ldb); const size_t hAc = (size_t)HALF * cur.lda * 2, hBc = (size_t)HALF * cur.ldb * 2;
      PG8_STAGE(PG8_SB(0, 0), cB, vBc, hBc / 2); PG8_STAGE(PG8_SB(0, 1), cB + hBc, vBc, hBc / 2); PG8_STAGE(PG8_SA(0, 0), cA, vAc, hAc / 2); PG8_STAGE(PG8_SA(0, 1), cA + hAc, vAc, hAc / 2);
      if (wr == 1) PG8_BAR;
      PG8_WAIT_V(2); PG8_BAR;
      PG8_STAGE(PG8_SB(1, 0), cB + kstep, vBc, hBc / 2); PG8_STAGE(PG8_SA(1, 0), cA + kstep, vAc, hAc / 2); PG8_STAGE(PG8_SB(1, 1), cB + hBc + kstep, vBc, hBc / 2);
      PG8_WAIT_V(6); PG8_BAR; }
    for (;;) {
        const bool has_next = S.next(ui + 1, nxt);
        if (!has_next) nxt = cur;
        const char* nA = nxt.A; const char* nB = nxt.B;
        const int nt = cur.nt;
        for (int t = 0; t < nt; t += 2) {
            const bool last = (t == nt - 2);
            const char* a1 = cA + (size_t)(t + 1) * kstep;
            const char* a2 = last ? nA : cA + (size_t)(t + 2) * kstep; const char* b2 = last ? nB : cB + (size_t)(t + 2) * kstep;
            const char* a3 = a2 + kstep; const char* b3 = b2 + kstep;
            const int lda2 = last ? nxt.lda : cur.lda, ldb2 = last ? nxt.ldb : cur.ldb;
            const unsigned vAc = PG8_VA(cur.lda), vA2 = PG8_VA(lda2), vB2 = PG8_VB(ldb2);
            const size_t hAc = (size_t)HALF * cur.lda * 2, hA2 = (size_t)HALF * lda2 * 2, hB2 = (size_t)HALF * ldb2 * 2;
            PG8_LDB(B0, 0, 0); PG8_LDB(B1, 0, 1); PG8_SCHED; PG8_LDA(At, 0, 0); PG8_STAGE(PG8_SA(1, 1), a1 + hAc, vAc, hAc / 2);
            PG8_WAIT_V(8); PG8_WAIT_L(0); PG8_BAR; PG8_MMA(0, 0, At, B0); PG8_MMA(0, 1, At, B1); PG8_BAR; PG8_SCHED;
            PG8_LDA(At, 0, 1); PG8_STAGE(PG8_SB(0, 0), b2, vB2, hB2 / 2); PG8_STAGE(PG8_SB(0, 1), b2 + hB2, vB2, hB2 / 2); PG8_STAGE(PG8_SA(0, 0), a2, vA2, hA2 / 2);
            PG8_WAIT_V(8); PG8_WAIT_L(0); PG8_BAR; PG8_MMA(1, 0, At, B0); PG8_MMA(1, 1, At, B1); PG8_BAR; PG8_SCHED;
            PG8_LDB(B0, 1, 0); PG8_LDB(B1, 1, 1); PG8_SCHED; PG8_LDA(At, 1, 0); PG8_STAGE(PG8_SA(0, 1), a2 + hA2, vA2, hA2 / 2);
            PG8_WAIT_V(8); PG8_WAIT_L(0); PG8_BAR; PG8_MMA(0, 0, At, B0); PG8_MMA(0, 1, At, B1); PG8_BAR; PG8_SCHED;
            PG8_LDA(At, 1, 1); PG8_STAGE(PG8_SB(1, 0), b3, vB2, hB2 / 2); PG8_STAGE(PG8_SB(1, 1), b3 + hB2, vB2, hB2 / 2); PG8_STAGE(PG8_SA(1, 0), a3, vA2, hA2 / 2);
            PG8_WAIT_V(8); PG8_WAIT_L(0); PG8_BAR; PG8_MMA(1, 0, At, B0); PG8_MMA(1, 1, At, B1); PG8_BAR; PG8_SCHED;
        }
        if (wr == 0) PG8_BAR;
        E(acc, cur, wr, wc, fr, fq);
        if (!has_next) break;
        if (!cur.keep) {
#pragma unroll
            for (int a = 0; a < 2; ++a)
#pragma unroll
                for (int b = 0; b < 2; ++b)
#pragma unroll
                    for (int m = 0; m < 4; ++m)
#pragma unroll
                        for (int n = 0; n < 2; ++n) acc[a][b][m][n] = (f32x4){0.f, 0.f, 0.f, 0.f};
        }
        cur = nxt; cA = nA; cB = nB; ++ui;
        if (wr == 1) PG8_BAR;
    }
    PG8_WAIT_V(0);
    PG8_BAR;
#undef PG8_SA
#undef PG8_SB
#undef PG8_STAGE
#undef PG8_LDA
#undef PG8_LDB
#undef PG8_MMA
#undef PG8_WAIT_V
#undef PG8_WAIT_L
#undef PG8_BAR
#undef PG8_SCHED
#undef PG8_VA
#undef PG8_VB
}

struct SchedOne {
    const bf16_t* A; const bf16_t* Bt; int nM, nN, nt, lda, ldb, a_pn_off, G, c; int nMx, pnx_lo, pnx_cnt;
    __device__ __forceinline__ bool next(int i, UnitD& u) const {
        const int L = i * G + c; int pm, pn;
        if (L < nM * nN) map_tile(L, nM, nN, pm, pn);
        else { const int Lx = L - nM * nN; if (Lx >= nMx * pnx_cnt) return false; pm = nM + Lx / pnx_cnt; pn = pnx_lo + Lx % pnx_cnt; }
        u.A = (const char*)(A + (size_t)pm * BM * lda + (size_t)pn * a_pn_off); u.B = (const char*)(Bt + (size_t)pn * BM * ldb);
        u.lda = lda; u.ldb = ldb; u.nt = nt; u.pm = pm; u.pn = pn; u.job = 0; u.keep = 0; return true;
    }
};
struct SchedThree {
    const bf16_t *A0, *A1, *A2, *B0, *B1, *B2; int nM0, nM1, nM2, nN0, nN1, nN2, nt0, nt1, nt2, lda0, lda1, lda2, ldb0, ldb1, ldb2, apn0, apn1, apn2; int G, c;
    __device__ __forceinline__ bool next(int i, UnitD& u) const {
        int L = i * G + c; const int n0 = nM0 * nN0, n1 = nM1 * nN1, n2 = nM2 * nN2;
        int pm, pn;
        if (L < n0) { map_tile(L, nM0, nN0, pm, pn); u.A = (const char*)(A0 + (size_t)pm * BM * lda0 + (size_t)pn * apn0); u.B = (const char*)(B0 + (size_t)pn * BM * ldb0); u.lda = lda0; u.ldb = ldb0; u.nt = nt0; u.job = 0; }
        else if (L < n0 + n1) { L -= n0; map_tile(L, nM1, nN1, pm, pn); u.A = (const char*)(A1 + (size_t)pm * BM * lda1 + (size_t)pn * apn1); u.B = (const char*)(B1 + (size_t)pn * BM * ldb1); u.lda = lda1; u.ldb = ldb1; u.nt = nt1; u.job = 1; }
        else if (L < n0 + n1 + n2) { L -= n0 + n1; map_tile(L, nM2, nN2, pm, pn); u.A = (const char*)(A2 + (size_t)pm * BM * lda2 + (size_t)pn * apn2); u.B = (const char*)(B2 + (size_t)pn * BM * ldb2); u.lda = lda2; u.ldb = ldb2; u.nt = nt2; u.job = 2; }
        else return false;
        u.pm = pm; u.pn = pn; u.keep = 0; return true;
    }
};
struct SchedP4 {
    unsigned char* ws; unsigned char* wsw; int nMall, nMlat, G, c;
    __device__ __forceinline__ bool next(int i, UnitD& u) const {
        int L = i * G + c; const int n0 = nMall * 16, n1 = nMlat * 16, n2 = nMlat * 4; int pm, pn;
        const bf16_t* pck = (const bf16_t*)(ws + WS_PCK);
        if (L < n0) { map_tile(L, nMall, 16, pm, pn); u.A = (const char*)(pck + (size_t)MT * 1536 + (size_t)pm * BM * 512); u.B = (const char*)((const bf16_t*)(wsw + WS_WUKV) + (size_t)pn * BM * 512); u.lda = 512; u.ldb = 512; u.nt = 8; u.job = 0; }
        else if (L < n0 + n1) { L -= n0; map_tile(L, nMlat, 16, pm, pn); u.A = (const char*)(pck + (size_t)MT * 1024 + (size_t)pm * BM * 512); u.B = (const char*)((const bf16_t*)(wsw + WS_WUQ) + (size_t)pn * BM * 512); u.lda = 512; u.ldb = 512; u.nt = 8; u.job = 1; }
        else if (L < n0 + n1 + n2) { L -= n0 + n1; map_tile(L, nMlat, 4, pm, pn); u.A = (const char*)(pck + (size_t)pm * BM * 1024 + (size_t)pn * 256); u.B = (const char*)((const bf16_t*)(wsw + WS_WPOOL) + (size_t)pn * BM * 256); u.lda = 1024; u.ldb = 256; u.nt = 4; u.job = 2; }
        else return false;
        u.pm = pm; u.pn = pn; u.keep = 0; return true;
    }
};
struct SchedChain3 {
    const bf16_t *A0, *A1, *A2, *B0, *B1, *B2; int nt0, nt1, nt2, lda0, lda1, lda2; int nM, nN, G, c;
    __device__ __forceinline__ bool next(int i, UnitD& u) const {
        const int tile = i / 3, br = i - tile * 3; const int L = tile * G + c; if (L >= nM * nN) return false;
        int pm, pn; map_tile(L, nM, nN, pm, pn);
        if (br == 0) { u.A = (const char*)(A0 + (size_t)pm * BM * lda0); u.B = (const char*)(B0 + (size_t)pn * BM * (nt0 * BK)); u.lda = lda0; u.ldb = nt0 * BK; u.nt = nt0; }
        else if (br == 1) { u.A = (const char*)(A1 + (size_t)pm * BM * lda1); u.B = (const char*)(B1 + (size_t)pn * BM * (nt1 * BK)); u.lda = lda1; u.ldb = nt1 * BK; u.nt = nt1; }
        else { u.A = (const char*)(A2 + (size_t)pm * BM * lda2); u.B = (const char*)(B2 + (size_t)pn * BM * (nt2 * BK)); u.lda = lda2; u.ldb = nt2 * BK; u.nt = nt2; }
        u.pm = pm; u.pn = pn; u.job = br; u.keep = br < 2; return true;
    }
};
struct SchedRes {
    const bf16_t* A; const bf16_t* Bt; int nMl, nMc, nN, nt, S, lda, G, c;
    __device__ __forceinline__ bool next(int i, UnitD& u) const {
        int L = i * G + c; const int nl = nMl * nN;
        if (L < nl) { int pm, pn; map_tile(L, nMl, nN, pm, pn);
            u.A = (const char*)(A + (size_t)pm * BM * lda); u.B = (const char*)(Bt + (size_t)pn * BM * lda); u.lda = lda; u.ldb = lda; u.nt = nt; u.pm = pm; u.pn = pn; u.job = 0; u.keep = 0; return true; }
        L -= nl; const int nc = nMc * nN; if (L >= nc * S) return false;
        const int s = L / nc, tl = L - s * nc; const int pm = nMl + tl / nN, pn = tl % nN; const int nts = nt / S;
        u.A = (const char*)(A + (size_t)pm * BM * lda + (size_t)s * nts * BK); u.B = (const char*)(Bt + (size_t)pn * BM * lda + (size_t)s * nts * BK);
        u.lda = lda; u.ldb = lda; u.nt = nts; u.pm = pm; u.pn = pn; u.job = 1 + s; u.keep = 0; return true;
    }
};

struct EpiStore {
    bf16_t *Oa, *Ob, *Oc; int ldca, ldcb, ldcc; const float* cs2; int sig_pn; int split_pn; bf16_t* O2; int ldc2;
    __device__ __forceinline__ void operator()(f32x4 (&acc)[2][2][4][2], const UnitD& u, int wr, int wc, int fr, int fq) const {
        const int row0 = u.pm * BM + wr * 64 + fr; const int j = u.job;
        bf16_t* base; int ld; const float* cs = nullptr; int colt = u.pn * BM;
        if (j == 0) { base = Oa; ld = ldca; } else if (j == 1) { base = Ob; ld = ldcb; } else { base = Oc; ld = ldcc; cs = cs2; }
        const bool img = u.pn >= split_pn;
        if (img) { base = O2; ld = ldc2; colt -= split_pn * BM; }
        const bool sig = u.pn >= sig_pn;
        const int col0 = colt + wc * 32 + 8 * fq, scol0 = u.pn * BM + wc * 32 + 8 * fq;
        f32x4 sv[2][2];
#pragma unroll
        for (int bj = 0; bj < 2; ++bj)
#pragma unroll
            for (int n = 0; n < 2; ++n) sv[bj][n] = cs ? *(const f32x4*)(cs + scol0 + bj * HALF + 4 * n) : (f32x4){1.f, 1.f, 1.f, 1.f};
#pragma unroll
        for (int ai = 0; ai < 2; ++ai)
#pragma unroll
            for (int m = 0; m < 4; ++m) { bf16_t* rowp = base + (size_t)(row0 + ai * HALF + m * 16) * ld + col0;
#pragma unroll
                for (int bj = 0; bj < 2; ++bj) { f32x4 v0 = acc[ai][bj][m][0] * sv[bj][0], v1 = acc[ai][bj][m][1] * sv[bj][1];
                    if (sig) {
#pragma unroll
                        for (int q = 0; q < 4; ++q) { v0[q] = sigmoidf_(v0[q]); v1[q] = sigmoidf_(v1[q]); } }
                    u32x4 w; w.x = cvt_pk_bf16(v0[0], v0[1]); w.y = cvt_pk_bf16(v0[2], v0[3]); w.z = cvt_pk_bf16(v1[0], v1[1]); w.w = cvt_pk_bf16(v1[2], v1[3]);
                    if (img) *((u32x4*)O2 + ((((size_t)u.pm * (GC / 256) + (u.pn - split_pn)) * 16 + (ai * 8 + m * 2 + bj)) * 8 + (wr * 4 + wc)) * 64 + (fq * 16 + fr)) = w;
                    else *(u32x4*)(rowp + bj * HALF) = w; } }
    }
};
struct EpiChainGate {
    const bf16_t* G; int ldg; bf16_t* O; int ld;
    __device__ __forceinline__ void operator()(f32x4 (&acc)[2][2][4][2], const UnitD& u, int wr, int wc, int fr, int fq) const {
        const int row0 = u.pm * BM + wr * 64 + fr, col0 = u.pn * BM + wc * 32 + 8 * fq; const int br = u.job;
#pragma unroll
        for (int ai = 0; ai < 2; ++ai)
#pragma unroll
            for (int m = 0; m < 4; ++m) { const size_t row = (size_t)(row0 + ai * HALF + m * 16);
#pragma unroll
                for (int bj = 0; bj < 2; ++bj) { const int col = col0 + bj * HALF;
                    const u32x4* gp = (const u32x4*)G + ((((size_t)u.pm * (GC / 256) + (br * (DM / 256) + u.pn)) * 16 + (ai * 8 + m * 2 + bj)) * 8 + (wr * 4 + wc)) * 64 + (fq * 16 + fr);
                    float gn[8]; unpack8(*gp, gn);
                    float f[8];
                    if (br < 2) { float gd[8]; unpack8(*(gp + (size_t)(DM / 256) * 16 * 8 * 64), gd);
#pragma unroll
                        for (int q = 0; q < 8; ++q) f[q] = gn[q] * __builtin_amdgcn_rcpf(fmaxf(gd[q], 1e-30f)); }
                    else {
#pragma unroll
                        for (int q = 0; q < 8; ++q) f[q] = gn[q]; }
                    f32x4 v0 = acc[ai][bj][m][0] * (f32x4){f[0], f[1], f[2], f[3]}, v1 = acc[ai][bj][m][1] * (f32x4){f[4], f[5], f[6], f[7]};
                    if (br < 2) { acc[ai][bj][m][0] = v0; acc[ai][bj][m][1] = v1; }
                    else { u32x4 w; w.x = cvt_pk_bf16(v0[0], v0[1]); w.y = cvt_pk_bf16(v0[2], v0[3]); w.z = cvt_pk_bf16(v1[0], v1[1]); w.w = cvt_pk_bf16(v1[2], v1[3]);
                        *(u32x4*)(O + row * ld + col) = w; } } }
    }
};
struct EpiRes {
    const float* in_lat; float* out_lat; float* out_ctx; const float* gate;
    __device__ __forceinline__ void operator()(f32x4 (&acc)[2][2][4][2], const UnitD& u, int wr, int wc, int fr, int fq) const {
        const bool lat = (u.job == 0);
        const int r = lat ? (u.pm >> 3) : 4;
        const int row0 = (lat ? u.pm : u.pm - ML / BM) * BM + wr * 64 + fr, col0 = u.pn * BM + wc * 32 + 8 * fq;
        const float* gp = gate + (size_t)r * MODW + col0;
        f32x4 gv[2][2];
#pragma unroll
        for (int bj = 0; bj < 2; ++bj)
#pragma unroll
            for (int n = 0; n < 2; ++n) gv[bj][n] = *(const f32x4*)(gp + bj * HALF + n * 4);
        if (lat) {
#pragma unroll
            for (int ai = 0; ai < 2; ++ai)
#pragma unroll
                for (int m = 0; m < 4; ++m) { const size_t off = (size_t)(row0 + ai * HALF + m * 16) * DM + col0;
#pragma unroll
                    for (int bj = 0; bj < 2; ++bj)
#pragma unroll
                        for (int n = 0; n < 2; ++n) { const size_t o2 = off + bj * HALF + n * 4; *(f32x4*)(out_lat + o2) = *(const f32x4*)(in_lat + o2) + gv[bj][n] * acc[ai][bj][m][n]; } }
        } else {
            float* part = out_ctx + (size_t)(u.job - 1) * MC * DM;
#pragma unroll
            for (int ai = 0; ai < 2; ++ai)
#pragma unroll
                for (int m = 0; m < 4; ++m) { const size_t off = (size_t)(row0 + ai * HALF + m * 16) * DM + col0;
#pragma unroll
                    for (int bj = 0; bj < 2; ++bj)
#pragma unroll
                        for (int n = 0; n < 2; ++n) *(f32x4*)(part + off + bj * HALF + n * 4) = gv[bj][n] * acc[ai][bj][m][n]; }
        }
    }
};

__device__ __forceinline__ float dpp_f(float v, const int ctrl_sel) {
    const int x = __float_as_int(v); int r;
    if (ctrl_sel == 0) r = __builtin_amdgcn_update_dpp(0, x, 0x111, 0xf, 0xf, true);
    else if (ctrl_sel == 1) r = __builtin_amdgcn_update_dpp(0, x, 0x101, 0xf, 0xf, true);
    else if (ctrl_sel == 2) r = __builtin_amdgcn_update_dpp(0, x, 0x121, 0xf, 0xf, true);
    else r = __builtin_amdgcn_update_dpp(0, x, 0x12F, 0xf, 0xf, true);
    return __int_as_float(r);
}
struct EpiFfn {
    bf16_t* F; const float* fc; float* side; LAS float* edge;
    __device__ __forceinline__ void operator()(f32x4 (&acc)[2][2][4][2], const UnitD& u, int wr, int wc, int fr, int fq) const {
        const int cl = wc * 32 + 8 * fq, col = u.pn * 128 + cl;
        f32x4 w0[2], w1[2], w2[2];
#pragma unroll
        for (int n = 0; n < 2; ++n) { w0[n] = *(const f32x4*)(fc + col + 4 * n); w1[n] = *(const f32x4*)(fc + DFF + col + 4 * n); w2[n] = *(const f32x4*)(fc + 2 * DFF + col + 4 * n); }
#pragma unroll
        for (int ai = 0; ai < 2; ++ai) { const int b = 2 * ai + wr;
            if (fr == 0) { *(LAS f32x4*)(edge + (b * 2 + 0) * 128 + cl) = acc[ai][0][0][0]; *(LAS f32x4*)(edge + (b * 2 + 0) * 128 + cl + 4) = acc[ai][0][0][1]; }
            if (fr == 15) { *(LAS f32x4*)(edge + (b * 2 + 1) * 128 + cl) = acc[ai][0][3][0]; *(LAS f32x4*)(edge + (b * 2 + 1) * 128 + cl + 4) = acc[ai][0][3][1]; } }
        asm volatile("s_waitcnt lgkmcnt(0)" ::: "memory"); __builtin_amdgcn_s_barrier(); asm volatile("" ::: "memory");
        const bool f0 = (fr == 0), f15 = (fr == 15);
#pragma unroll
        for (int ai = 0; ai < 2; ++ai) { const int b = 2 * ai + wr;
            f32x4 pe[2], ne[2];
#pragma unroll
            for (int n = 0; n < 2; ++n) { pe[n] = (b > 0) ? *(const LAS f32x4*)(edge + ((b - 1) * 2 + 1) * 128 + cl + 4 * n) : (f32x4){0.f, 0.f, 0.f, 0.f};
                                          ne[n] = (b < 3) ? *(const LAS f32x4*)(edge + ((b + 1) * 2 + 0) * 128 + cl + 4 * n) : (f32x4){0.f, 0.f, 0.f, 0.f}; }
#pragma unroll
            for (int m = 0; m < 4; ++m) { float o8[8];
#pragma unroll
                for (int n = 0; n < 2; ++n)
#pragma unroll
                    for (int q = 0; q < 4; ++q) {
                        const float cur = acc[ai][0][m][n][q];
                        const float shr = dpp_f(cur, 0), shl = dpp_f(cur, 1);
                        const float pv = (m > 0) ? dpp_f(acc[ai][0][m > 0 ? m - 1 : 0][n][q], 2) : pe[n][q];
                        const float nv = (m < 3) ? dpp_f(acc[ai][0][m < 3 ? m + 1 : 3][n][q], 3) : ne[n][q];
                        const float prev = f0 ? pv : shr, next = f15 ? nv : shl;
                        const float cv = (prev * w0[n][q] + cur * w1[n][q]) + next * w2[n][q];
                        o8[n * 4 + q] = cv * sigmoidf_(cv) * acc[ai][1][m][n][q]; }
                const size_t row = (size_t)u.pm * BM + ai * HALF + wr * 64 + m * 16 + fr;
                *(u32x4*)(F + row * DFF + col) = pack8(o8); } }
        if (u.pm < ML / BM) { float* sp = side + (size_t)u.pm * 6 * DFF + col;
            if (wr == 0 && fr < 2) { *(f32x4*)(sp + (size_t)fr * DFF) = acc[0][0][0][0]; *(f32x4*)(sp + (size_t)fr * DFF + 4) = acc[0][0][0][1];
                if (fr == 0) { *(f32x4*)(sp + (size_t)4 * DFF) = acc[0][1][0][0]; *(f32x4*)(sp + (size_t)4 * DFF + 4) = acc[0][1][0][1]; } }
            if (wr == 1 && fr >= 14) { *(f32x4*)(sp + (size_t)(fr - 12) * DFF) = acc[1][0][3][0]; *(f32x4*)(sp + (size_t)(fr - 12) * DFF + 4) = acc[1][0][3][1];
                if (fr == 15) { *(f32x4*)(sp + (size_t)5 * DFF) = acc[1][1][3][0]; *(f32x4*)(sp + (size_t)5 * DFF + 4) = acc[1][1][3][1]; } } }
    }
};

struct EpiHeads {
    unsigned char* ws; const float *qhg, *khg, *pscale; LAS float* rs;
    __device__ __forceinline__ void operator()(f32x4 (&acc)[2][2][4][2], const UnitD& u, int wr, int wc, int fr, int fq) const {
        bf16_t* const QNp = (bf16_t*)(ws + WS_QK); bf16_t* const QNCp = QNp + (size_t)64 * SEQ * 192; bf16_t* const KNp = QNp + (size_t)64 * SKV * 192; bf16_t* const VNp = (bf16_t*)(ws + WS_VN);
        const bf16_t* const KRp = (const bf16_t*)(ws + WS_KR); const float* const KRSSp = (const float*)(ws + WS_KRSS); bf16_t* const MAp = (bf16_t*)(ws + WS_MA);
        const int c8 = wc * 32 + 8 * fq;
        if (u.job == 2) {
            const int row0 = u.pm * BM + wr * 64 + fr, col0 = u.pn * BM + c8;
            f32x4 sv[2][2];
#pragma unroll
            for (int bj = 0; bj < 2; ++bj)
#pragma unroll
                for (int n = 0; n < 2; ++n) sv[bj][n] = *(const f32x4*)(pscale + col0 + bj * HALF + 4 * n);
#pragma unroll
            for (int ai = 0; ai < 2; ++ai)
#pragma unroll
                for (int m = 0; m < 4; ++m) { bf16_t* rowp = MAp + (size_t)(row0 + ai * HALF + m * 16) * 1024 + col0;
#pragma unroll
                    for (int bj = 0; bj < 2; ++bj) { const f32x4 v0 = acc[ai][bj][m][0] * sv[bj][0], v1 = acc[ai][bj][m][1] * sv[bj][1];
                        u32x4 w; w.x = cvt_pk_bf16(v0[0], v0[1]); w.y = cvt_pk_bf16(v0[2], v0[3]); w.z = cvt_pk_bf16(v1[0], v1[1]); w.w = cvt_pk_bf16(v1[2], v1[3]);
                        *(u32x4*)(rowp + bj * HALF) = w; } }
            return;
        }
        const bool isq = (u.job == 1); const int h = u.pn; const bool lat = u.pm < ML / BM;
        int fql = fq; asm volatile("" : "+v"(fql));
        const bool hi64 = isq && wc < 2;
#pragma unroll
        for (int ai = 0; ai < 2; ++ai)
#pragma unroll
            for (int m = 0; m < 4; ++m) { float s = 0.f;
#pragma unroll
                for (int n = 0; n < 2; ++n) { const f32x4 x = acc[ai][0][m][n]; s += (x[0] * x[0] + x[1] * x[1]) + (x[2] * x[2] + x[3] * x[3]); }
                if (hi64) {
#pragma unroll
                    for (int n = 0; n < 2; ++n) { const f32x4 x = acc[ai][1][m][n]; s += (x[0] * x[0] + x[1] * x[1]) + (x[2] * x[2] + x[3] * x[3]); } }
                s += shx(s, 16); s += shx(s, 32);
                if (fq == 0) rs[(ai * HALF + wr * 64 + m * 16 + fr) * 4 + wc] = s; }
        asm volatile("s_waitcnt lgkmcnt(0)" ::: "memory"); __builtin_amdgcn_s_barrier(); asm volatile("" ::: "memory");
        const float* hg = isq ? qhg : khg;
        const f32x4 g00 = *(const f32x4*)(hg + c8), g01 = *(const f32x4*)(hg + c8 + 4);
        constexpr float LF = 0.830482023721841f;
#pragma unroll
        for (int ai = 0; ai < 2; ++ai)
#pragma unroll
            for (int m = 0; m < 4; ++m) {
                const int rl = ai * HALF + wr * 64 + m * 16 + fr, grow = u.pm * BM + rl;
                const f32x4 p4 = *(const LAS f32x4*)(rs + rl * 4); float tot = (p4[0] + p4[1]) + (p4[2] + p4[3]);
                if (!isq) tot += KRSSp[grow];
                const float rstd = rsqrtf(tot * (1.f / 192.f) + EPS);
                const int b = lat ? (grow >> 11) : ((grow - ML) >> 8), pos = lat ? (grow & (SEQ - 1)) : ((grow - ML) & (CTXL - 1));
                const size_t bh = (size_t)b * NH + h;
                const f32x4 v0 = acc[ai][0][m][0] * rstd * g00, v1 = acc[ai][0][m][1] * rstd * g01;
                u32x4 w; w.x = cvt_pk_bf16(v0[0], v0[1]); w.y = cvt_pk_bf16(v0[2], v0[3]); w.z = cvt_pk_bf16(v1[0], v1[1]); w.w = cvt_pk_bf16(v1[2], v1[3]);
                if (isq) {
                    bf16_t* qo = lat ? QNp + (bh * SEQ + pos) * 192 : QNCp + (bh * CTXL + pos) * 192;
                    *(u32x4*)(qo + c8) = w;
                    if (wc < 2) {
                        const float pc = (float)((wc == 0) ? (pos >> 6) : (pos & 63));
#pragma unroll
                        for (int n = 0; n < 2; ++n) { const f32x4 g1 = *(const f32x4*)(hg + 128 + c8 + 4 * n); const f32x4 x = acc[ai][1][m][n] * rstd * g1; float o4[4];
#pragma unroll
                            for (int q = 0; q < 4; ++q) { const float pr = shx(x[q], 32);
                                float cs = 1.f, sn = 0.f;
                                if (lat) { const float ang = pc * __builtin_amdgcn_exp2f(-(float)(8 * (fql & 1) + 4 * n + q) * LF); cs = __cosf(ang); sn = __sinf(ang); }
                                o4[q] = (fq < 2) ? (x[q] * cs - pr * sn) : (pr * sn + x[q] * cs); }
                            u32x2 wq; wq.x = cvt_pk_bf16(o4[0], o4[1]); wq.y = cvt_pk_bf16(o4[2], o4[3]);
                            *(u32x2*)(qo + 128 + c8 + 4 * n) = wq; }
                    }
                } else {
                    const int kpos = lat ? pos : SEQ + pos;
                    bf16_t* ko = KNp + (bh * SKV + kpos) * 192;
                    *(u32x4*)(ko + c8) = w;
                    const f32x4 a0 = acc[ai][1][m][0], a1 = acc[ai][1][m][1];
                    u32x4 wv; wv.x = cvt_pk_bf16(a0[0], a0[1]); wv.y = cvt_pk_bf16(a0[2], a0[3]); wv.z = cvt_pk_bf16(a1[0], a1[1]); wv.w = cvt_pk_bf16(a1[2], a1[3]);
                    *(u32x4*)(VNp + (bh * SKV + kpos) * 128 + c8) = wv;
                    const int d0 = 16 * wc + 4 * fq;
                    const u32x2 ow = *(const u32x2*)(KRp + (size_t)grow * 64 + d0), pw = *(const u32x2*)(KRp + (size_t)grow * 64 + (d0 ^ 16));
                    const f32x4 go = *(const f32x4*)(hg + 128 + d0), gq = *(const f32x4*)(hg + 128 + (d0 ^ 16));
                    const float xo[4] = {bf_lo(ow.x), bf_hi(ow.x), bf_lo(ow.y), bf_hi(ow.y)}, xp[4] = {bf_lo(pw.x), bf_hi(pw.x), bf_lo(pw.y), bf_hi(pw.y)};
                    const float pc = (float)((wc < 2) ? (pos >> 6) : (pos & 63));
                    float o4[4];
#pragma unroll
                    for (int q = 0; q < 4; ++q) { const float x = xo[q] * rstd * go[q], y = xp[q] * rstd * gq[q];
                        float cs = 1.f, sn = 0.f;
                        if (lat) { const float ang = pc * __builtin_amdgcn_exp2f(-(float)(4 * fql + q) * LF); cs = __cosf(ang); sn = __sinf(ang); }
                        o4[q] = ((wc & 1) == 0) ? (x * cs - y * sn) : (y * sn + x * cs); }
                    u32x2 wk; wk.x = cvt_pk_bf16(o4[0], o4[1]); wk.y = cvt_pk_bf16(o4[2], o4[3]);
                    *(u32x2*)(ko + 128 + d0) = wk;
                }
                asm volatile("" ::: "memory"); __builtin_amdgcn_sched_barrier(0);
            }
    }
};
}

namespace att {
constexpr int DQK = 192, DV = 128, KVBLK = 64;
constexpr float SCALE = 0.07216878364870322f;
constexpr float THR = 8.f;
constexpr int SHM_K = KVBLK * DQK * 2, SHM_V = KVBLK * DV * 2;
#define KSWZ(row, colB) ((row) * 384 + ((colB) ^ (((row) & 7) << 4)))
#define SBAR() __builtin_amdgcn_sched_barrier(0)
__device__ __forceinline__ int crow(int r, int hi) { return (r & 3) + 8 * (r >> 2) + 4 * hi; }
__device__ __forceinline__ void partialSM(f32x16& p0, f32x16& p1, float& m_reg, float& mn, float& alpha) {
    constexpr float C = SCALE * 1.4426950408889634f;
    float pmax = p0[0];
#pragma unroll
    for (int r = 1; r < 16; ++r) pmax = fmaxf(pmax, p0[r]);
#pragma unroll
    for (int r = 0; r < 16; ++r) pmax = fmaxf(pmax, p1[r]);
    { auto rr = __builtin_amdgcn_permlane32_swap(__float_as_uint(pmax), __float_as_uint(pmax), false, false);
      pmax = fmaxf(__uint_as_float(rr[0]), __uint_as_float(rr[1])); }
    if (__builtin_expect(__all(pmax - m_reg <= THR / SCALE), 1)) { mn = m_reg; alpha = 1.f; }
    else { mn = fmaxf(m_reg, pmax); alpha = __builtin_amdgcn_exp2f((m_reg - mn) * C); m_reg = mn; }
    const float mnC = -mn * C;
#pragma unroll
    for (int r = 0; r < 16; ++r) p0[r] = __builtin_amdgcn_exp2f(fmaf(p0[r], C, mnC));
#pragma unroll
    for (int r = 0; r < 16; ++r) p1[r] = __builtin_amdgcn_exp2f(fmaf(p1[r], C, mnC));
}
__device__ __forceinline__ void finishSM(f32x16& p0, f32x16& p1, float& l_reg, bf16x8& pa0, bf16x8& pa1, bf16x8& pa2, bf16x8& pa3) {
    float ps = 0;
#pragma unroll
    for (int r = 0; r < 16; ++r) ps += p0[r];
#pragma unroll
    for (int r = 0; r < 16; ++r) ps += p1[r];
    { auto rr = __builtin_amdgcn_permlane32_swap(__float_as_uint(ps), __float_as_uint(ps), false, false);
      ps = __uint_as_float(rr[0]) + __uint_as_float(rr[1]); }
    l_reg += ps;
#define PK4(P, BASE, OUT) do { unsigned a0 = cvt_pk_bf16(P[BASE + 0], P[BASE + 1]), a1 = cvt_pk_bf16(P[BASE + 2], P[BASE + 3]);   \
    unsigned b0 = cvt_pk_bf16(P[BASE + 4], P[BASE + 5]), b1 = cvt_pk_bf16(P[BASE + 6], P[BASE + 7]);                              \
    auto r0 = __builtin_amdgcn_permlane32_swap(a0, b0, false, false); auto r1 = __builtin_amdgcn_permlane32_swap(a1, b1, false, false); \
    u32x4 w = {r0[0], r1[0], r0[1], r1[1]}; OUT = *reinterpret_cast<bf16x8*>(&w); } while (0)
    PK4(p0, 0, pa0); PK4(p0, 8, pa1); PK4(p1, 0, pa2); PK4(p1, 8, pa3);
#undef PK4
}
__device__ __forceinline__ void qkt(f32x16& p0, f32x16& p1, const char* Ks, const bf16x8* qr, int r32, int hi) {
    p0 = f32x16{}; p1 = f32x16{};
#pragma unroll
    for (int d0 = 0; d0 < 12; ++d0) { const int cb = (d0 * 16 + hi * 8) * 2;
        bf16x8 b0 = *reinterpret_cast<const bf16x8*>(Ks + KSWZ(r32, cb));
        bf16x8 b1 = *reinterpret_cast<const bf16x8*>(Ks + KSWZ(32 + r32, cb));
        p0 = __builtin_amdgcn_mfma_f32_32x32x16_bf16(b0, qr[d0], p0, 0, 0, 0);
        p1 = __builtin_amdgcn_mfma_f32_32x32x16_bf16(b1, qr[d0], p1, 0, 0, 0); }
}
__device__ __forceinline__ int v_st(int k, int c) { const int kk = (k & ~0xC) | ((k & 4) << 1) | ((k & 8) >> 1); return ((kk >> 3) * 4 + (c >> 5)) * 512 + ((kk & 7) * 32 + (c & 31)) * 2; }
__device__ __forceinline__ int v_rd_base(int lane) { return ((lane & 3) << 3) | (((lane >> 2) & 3) << 6) | (((lane >> 4) & 1) << 5) | (((lane >> 5) & 1) << 8); }
constexpr int v_rd_off(int d0, int ks, int half) { return d0 * 512 + ks * 4096 + half * 2048; }
template <int OFF> __device__ __forceinline__ s16x4 tr_read(int vb) {
    s16x4 r; asm volatile("ds_read_b64_tr_b16 %0, %1 offset:%2" : "=&v"(r) : "v"(vb), "i"(OFF) : "memory"); return r;
}
template <int D0> __device__ __forceinline__ void pv_one(f32x16& od, int vb, bf16x8 pa0, bf16x8 pa1, bf16x8 pa2, bf16x8 pa3) {
    const s16x4 l0 = tr_read<v_rd_off(D0, 0, 0)>(vb), h0 = tr_read<v_rd_off(D0, 0, 1)>(vb), l1 = tr_read<v_rd_off(D0, 1, 0)>(vb), h1 = tr_read<v_rd_off(D0, 1, 1)>(vb);
    const s16x4 l2 = tr_read<v_rd_off(D0, 2, 0)>(vb), h2 = tr_read<v_rd_off(D0, 2, 1)>(vb), l3 = tr_read<v_rd_off(D0, 3, 0)>(vb), h3 = tr_read<v_rd_off(D0, 3, 1)>(vb);
    asm volatile("s_waitcnt lgkmcnt(0)" ::: "memory"); SBAR();
#define PKV(L, H) (bf16x8){L[0], L[1], L[2], L[3], H[0], H[1], H[2], H[3]}
    od = __builtin_amdgcn_mfma_f32_32x32x16_bf16(pa0, PKV(l0, h0), od, 0, 0, 0);
    od = __builtin_amdgcn_mfma_f32_32x32x16_bf16(pa1, PKV(l1, h1), od, 0, 0, 0);
    od = __builtin_amdgcn_mfma_f32_32x32x16_bf16(pa2, PKV(l2, h2), od, 0, 0, 0);
    od = __builtin_amdgcn_mfma_f32_32x32x16_bf16(pa3, PKV(l3, h3), od, 0, 0, 0);
#undef PKV
}
__device__ __forceinline__ void attn_unit(const bf16_t* Qb, const bf16_t* Kh, const bf16_t* Vh, bf16_t* Ob, int ldo, int seq, char* lds, const int cx_wave) {
    int tid_l = TID_(); asm volatile("" : "+v"(tid_l));
    const int tid = tid_l, wid = tid >> 6, lane = tid & 63, r32 = lane & 31, hi = lane >> 5;
    char* V_lds = lds; char* K_lds = lds + 3 * SHM_V;
    float* wsf = (float*)(lds + 3 * SHM_V + 3 * SHM_K) + wid * 64; float* li_l = wsf; float* al_l = wsf + 32;
    float m_reg = -1e30f, l_reg = 0.f; f32x16 o[4] = {}; bf16x8 qr[12];
    const bf16_t* Qw = Qb + (size_t)(wid * 32 + r32) * DQK + hi * 8;
#pragma unroll
    for (int d0 = 0; d0 < 12; ++d0) qr[d0] = *reinterpret_cast<const bf16x8*>(Qw + d0 * 16);
    const int p0 = tid, p1 = tid + 512, p2 = tid + 1024;
    const int ko0 = (p0 / 24) * DQK + (((p0 % 24) ^ ((p0 / 24) & 7)) * 8), ko1 = (p1 / 24) * DQK + (((p1 % 24) ^ ((p1 / 24) & 7)) * 8), ko2 = (p2 / 24) * DQK + (((p2 % 24) ^ ((p2 / 24) & 7)) * 8);
    const int q0 = tid, q1 = tid + 512;
    const int kk0 = ((q0 >> 7) << 3) | ((q0 >> 2) & 7), kk1 = ((q1 >> 7) << 3) | ((q1 >> 2) & 7);
    const int vk0 = (kk0 & ~0xC) | ((kk0 & 4) << 1) | ((kk0 & 8) >> 1), vk1 = (kk1 & ~0xC) | ((kk1 & 4) << 1) | ((kk1 & 8) >> 1);
    const int vo0 = vk0 * DV + ((((q0 >> 5) & 3) << 5) | ((q0 & 3) << 3)), vo1 = vk1 * DV + ((((q1 >> 5) & 3) << 5) | ((q1 & 3) << 3));
    const int vb0 = (int)(uintptr_t)V_lds + v_rd_base(lane);
    LAS char* K_ldsl = (LAS char*)(uintptr_t)(unsigned)(uintptr_t)K_lds; LAS char* V_ldsl = (LAS char*)(uintptr_t)(unsigned)(uintptr_t)V_lds;
    const unsigned kw = (unsigned)__builtin_amdgcn_readfirstlane(wid) * 1024u;
#define SLOAD(k0, rb) do { const bf16_t* kp_ = Kh + (size_t)(k0) * DQK; const bf16_t* vp_ = Vh + (size_t)(k0) * DV; \
    __builtin_amdgcn_global_load_lds((const unsigned*)(kp_ + ko0), (LAS unsigned*)(K_ldsl + (rb) * SHM_K + kw), 16, 0, 0); \
    __builtin_amdgcn_global_load_lds((const unsigned*)(kp_ + ko1), (LAS unsigned*)(K_ldsl + (rb) * SHM_K + kw + 8192), 16, 0, 0); \
    __builtin_amdgcn_global_load_lds((const unsigned*)(kp_ + ko2), (LAS unsigned*)(K_ldsl + (rb) * SHM_K + kw + 16384), 16, 0, 0); \
    __builtin_amdgcn_global_load_lds((const unsigned*)(vp_ + vo0), (LAS unsigned*)(V_ldsl + (rb) * SHM_V + kw), 16, 0, 0); \
    __builtin_amdgcn_global_load_lds((const unsigned*)(vp_ + vo1), (LAS unsigned*)(V_ldsl + (rb) * SHM_V + kw + 8192), 16, 0, 0); } while (0)
#define SWAIT() asm volatile("s_waitcnt vmcnt(0)" ::: "memory")
    const int NT = seq / KVBLK;
#define RESC(a) do { l_reg *= (a); if (__any((a) < 1.f)) { if (hi == 0) al_l[r32] = (a); asm volatile("s_waitcnt lgkmcnt(0)" ::: "memory"); \
    _Pragma("unroll") for (int d = 0; d < 4; ++d) _Pragma("unroll") for (int r = 0; r < 16; ++r) o[d][r] *= al_l[crow(r, hi)]; } } while (0)
#define PV(vbuf) do { const int vb_ = vb0 + (vbuf) * SHM_V; pv_one<0>(o[0], vb_, pa0, pa1, pa2, pa3); pv_one<1>(o[1], vb_, pa0, pa1, pa2, pa3); pv_one<2>(o[2], vb_, pa0, pa1, pa2, pa3); pv_one<3>(o[3], vb_, pa0, pa1, pa2, pa3); } while (0)
    f32x16 pA0, pA1, pB0, pB1; float mnA, mnB, alA, alB; bf16x8 pa0, pa1, pa2, pa3;
    SLOAD(0, 0); SWAIT(); __syncthreads();
    qkt(pA0, pA1, K_lds, qr, r32, hi); partialSM(pA0, pA1, m_reg, mnA, alA);
    SLOAD(KVBLK, 1); SWAIT(); __syncthreads();
    for (int j = 1; j + 1 < NT; j += 2) {
        const int kj = j % 3, kj1 = (j + 1) % 3, kj2 = (j + 2) % 3, kjm = (j + 2) % 3;
        SBAR(); qkt(pB0, pB1, K_lds + kj * SHM_K, qr, r32, hi);
        finishSM(pA0, pA1, l_reg, pa0, pa1, pa2, pa3); SBAR();
        SLOAD((j + 1) * KVBLK, kj1); SBAR();
        PV(kjm); partialSM(pB0, pB1, m_reg, mnB, alB);
        SWAIT(); __syncthreads();
        RESC(alB);
        SBAR(); qkt(pA0, pA1, K_lds + kj1 * SHM_K, qr, r32, hi);
        finishSM(pB0, pB1, l_reg, pa0, pa1, pa2, pa3); SBAR();
        SLOAD((j + 2) * KVBLK, kj2); SBAR();
        PV(kj); partialSM(pA0, pA1, m_reg, mnA, alA);
        SWAIT(); __syncthreads();
        RESC(alA);
    }
    SBAR(); qkt(pB0, pB1, K_lds + ((NT - 1) % 3) * SHM_K, qr, r32, hi);
    finishSM(pA0, pA1, l_reg, pa0, pa1, pa2, pa3); SBAR();
    PV((NT - 2) % 3); partialSM(pB0, pB1, m_reg, mnB, alB);
    RESC(alB);
    finishSM(pB0, pB1, l_reg, pa0, pa1, pa2, pa3); SBAR();
    PV((NT - 1) % 3);
#undef RESC
#undef PV
#undef SWAIT
    if (hi == 0) li_l[r32] = l_reg; asm volatile("s_waitcnt lgkmcnt(0)" ::: "memory");
    bf16_t* Ow = Ob + (size_t)(wid * 32) * ldo;
#pragma unroll
    for (int r = 0; r < 16; ++r) { const int orow = crow(r, hi); const float rl = __builtin_amdgcn_rcpf(li_l[orow]);
#pragma unroll
        for (int d0 = 0; d0 < 4; ++d0) Ow[(size_t)orow * ldo + d0 * 32 + r32] = f2bf(o[d0][r] * rl); }
    __syncthreads();
#undef SLOAD
#undef SWRITE
}
}


#define XB_TMO      128
#define XB_XCNT(j)  (256  + 64 * (j))
#define XB_XSUB(j)  (1280 + 64 * (j))
#define XB_XGEN(j)  (2304 + 64 * (j))
#define XB_TOP      3328
#define XB_TOPGEN   3392
#define XCD_BAR_WORDS 3456
#define XB_SPIN_CAP (1u << 18)
__device__ __forceinline__ unsigned xb_ld(unsigned* p)              { return __hip_atomic_load(p, __ATOMIC_RELAXED, __HIP_MEMORY_SCOPE_AGENT); }
__device__ __forceinline__ unsigned xb_add(unsigned* p, unsigned v) { return __hip_atomic_fetch_add(p, v, __ATOMIC_RELAXED, __HIP_MEMORY_SCOPE_AGENT); }
__device__ __forceinline__ unsigned xb_xcc_id() { return (unsigned)__builtin_amdgcn_s_getreg((3 << 11) | 20) & 0xFu; }
#define XB_SPIN(cond, bar) do { unsigned _sp = 0; while (cond) { __builtin_amdgcn_s_sleep(1); \
    if ((++_sp & 255u) == 0u) { if (xb_ld(&(bar)[XB_TMO])) break; if (_sp > XB_SPIN_CAP) { atomicAdd(&(bar)[XB_TMO], 1u); break; } } } } while (0)
__device__ __forceinline__ void xcd_barrier_post(unsigned* bar, int tid) { if (tid == 0) (void)xb_add(&bar[XB_XCNT(xb_xcc_id())], 1u); }
__device__ __forceinline__ void xcd_barrier_complete(unsigned* bar, unsigned x, unsigned& nloc, unsigned& nx) {
    const unsigned G = gridDim.x;
    unsigned sum, cnt, mine, sp = 0u;
    for (;;) {
        sum = 0u; cnt = 0u; mine = 0u;
#pragma unroll
        for (unsigned j = 0; j < 16; ++j) { const unsigned c = xb_ld(&bar[XB_XCNT(j)]); sum += c; cnt += (c > 0u) ? 1u : 0u; mine = (j == x) ? c : mine; }
        if (sum == G) break;
        __builtin_amdgcn_s_sleep(1);
        if ((++sp & 255u) == 0u) { if (xb_ld(&bar[XB_TMO])) break; if (sp > XB_SPIN_CAP) { atomicAdd(&bar[XB_TMO], 1u); break; } }
    }
    nloc = mine > 0u ? mine : 1u; nx = cnt > 0u ? cnt : 1u;
}
__device__ __forceinline__ void xcd_barrier(unsigned* bar, volatile LAS unsigned* st, int tid) {
    asm volatile("s_waitcnt vmcnt(0)" ::: "memory");
    __syncthreads();
    if (tid == 0) {
        const unsigned x = xb_xcc_id();
        __builtin_amdgcn_s_waitcnt(0);
        unsigned nloc = st[0], nx = st[1];
        if (nloc == 0u) { xcd_barrier_complete(bar, x, nloc, nx); st[0] = nloc; st[1] = nx; }
        const unsigned old = xb_add(&bar[XB_XSUB(x)], 1u);
        const unsigned gen = old / nloc;
        if (old + 1u == (gen + 1u) * nloc) {
            __builtin_amdgcn_fence(__ATOMIC_RELEASE, "agent");
            asm volatile("s_waitcnt vmcnt(0)" ::: "memory");
            const unsigned og = xb_add(&bar[XB_TOP], 1u);
            const unsigned tg = og / nx;
            if (og + 1u == (tg + 1u) * nx) xb_add(&bar[XB_TOPGEN], 1u);
            else XB_SPIN(xb_ld(&bar[XB_TOPGEN]) == tg, bar);
            __builtin_amdgcn_fence(__ATOMIC_ACQUIRE, "agent");
            xb_add(&bar[XB_XGEN(x)], 1u);
            asm volatile("s_waitcnt vmcnt(0)" ::: "memory");
        } else {
            XB_SPIN(xb_ld(&bar[XB_XGEN(x)]) == gen, bar);
            __builtin_amdgcn_fence(__ATOMIC_ACQUIRE, "agent");
            asm volatile("s_waitcnt vmcnt(0)" ::: "memory");
        }
    }
    __syncthreads();
}

struct Args { const float* in[25]; float* out; unsigned char* ws; int flag, pad; };

__device__ __forceinline__ void transpose_item(const float* W, int K, int N, bf16_t* WT, int row_off, int pad_from, int pad_amt, LAS float* scr, int item, int lane) {
    const int nblk = N / 32, kb = item / nblk, nb = item % nblk, k0 = 64 * kb, n0 = 32 * nb;
    const int roff = row_off + (n0 >= pad_from ? pad_amt : 0);
    float tv[32];
#pragma unroll
    for (int i = 0; i < 32; ++i) { const int kk = 2 * i + (lane >> 5); tv[i] = W[(size_t)(k0 + kk) * N + n0 + (lane & 31)]; }
#pragma unroll
    for (int i = 0; i < 32; ++i) { const int kk = 2 * i + (lane >> 5); scr[kk * 33 + (lane & 31)] = tv[i]; }
    asm volatile("s_waitcnt lgkmcnt(0)" ::: "memory");
    const int c = lane & 7;
#pragma unroll
    for (int j = 0; j < 4; ++j) { const int n = (lane >> 3) + 8 * j; const LAS float* s = scr + (8 * c) * 33 + n;
        u32x4 o; o.x = cvt_pk_bf16(s[0 * 33], s[1 * 33]); o.y = cvt_pk_bf16(s[2 * 33], s[3 * 33]); o.z = cvt_pk_bf16(s[4 * 33], s[5 * 33]); o.w = cvt_pk_bf16(s[6 * 33], s[7 * 33]);
        *(u32x4*)(WT + (size_t)(roff + n0 + n) * K + k0 + 8 * c) = o; }
    asm volatile("s_waitcnt lgkmcnt(0)" ::: "memory");
}

extern __shared__ __attribute__((aligned(16))) unsigned char lds[];
typedef __attribute__((address_space(4))) const Args* KArgs;
struct Ctx { KArgs ka0; int wave; };
#ifndef REP_MASK
#define REP_MASK 0
#endif
#ifndef SYNC_REP
#define SYNC_REP 1
#endif
#define PH_BEGIN(ID) for (int rep_ = 0; rep_ < (((REP_MASK >> (ID)) & 1) ? 2 : 1); ++rep_) { if (rep_) { KArgs kb = ka0; asm volatile("" : "+s"(kb)); xcd_barrier((unsigned*)(kb->ws + WS_BAR), bst, TID_()); } KArgs ka = ka0; asm volatile("" : "+s"(ka)); int tid = TID_(); asm volatile("" : "+v"(tid)); \
    const int G = gridDim.x, bid = blockIdx.x, NGW = G * 8, NGT = G * 512; const int lane = tid & 63, wave = __builtin_amdgcn_readfirstlane(tid >> 6); const int gw = bid * 8 + wave, gt = bid * 512 + tid; unsigned char* const ws = ka->ws; \
    (void)lane; (void)wave; (void)gw; (void)gt; (void)ws; (void)NGW; (void)NGT;
#define PH_END(LASTPH) } if (!(LASTPH)) { for (int sr_ = 0; sr_ < SYNC_REP; ++sr_) { KArgs kb = ka0; asm volatile("" : "+s"(kb)); xcd_barrier((unsigned*)(kb->ws + WS_BAR), bst, TID_()); } }
#define IN(k) (ka->in[k])
#define OUTP (ka->out)
#define WIN ((bf16_t*)(ws + WS_WIN + (size_t)wl * WSET))
#define WPOOL ((bf16_t*)(ws + WS_WPOOL + (size_t)wl * WSET))
#define WUQ ((bf16_t*)(ws + WS_WUQ + (size_t)wl * WSET))
#define WUKV ((bf16_t*)(ws + WS_WUKV + (size_t)wl * WSET))
#define WBA ((bf16_t*)(ws + WS_WBA + (size_t)wl * WSET))
#define WBB ((bf16_t*)(ws + WS_WBB + (size_t)wl * WSET))
#define WBC ((bf16_t*)(ws + WS_WBC + (size_t)wl * WSET))
#define WOUT ((bf16_t*)(ws + WS_WOUT + (size_t)wl * WSET))
#define WUP ((bf16_t*)(ws + WS_WUP + (size_t)wl * WSET))
#define WDN ((bf16_t*)(ws + WS_WDN + (size_t)wl * WSET))
#define MOD ((float*)(ws + WS_MOD) + (size_t)wl * 5 * MODW)
#define H ((bf16_t*)(ws + WS_H))
#define MERGED H
#define Z1 ((bf16_t*)(ws + WS_Z1))
#define QRAW Z1
#define UV Z1
#define GB ((bf16_t*)(ws + WS_G))
#define POOLED ((bf16_t*)(ws + WS_PCK))
#define CQ (POOLED + (size_t)MT * 1024)
#define CKV (CQ + (size_t)MT * 512)
#define OB POOLED
#define U ((bf16_t*)(ws + WS_U))
#define MA ((bf16_t*)(ws + WS_MA))
#define QN ((bf16_t*)(ws + WS_QK))
#define QNC (QN + (size_t)64 * SEQ * 192)
#define KN (QN + (size_t)64 * SKV * 192)
#define TMP ((float*)(ws + WS_QK))
#define FB ((bf16_t*)(ws + WS_QK))
#define VN ((bf16_t*)(ws + WS_VN))
#define KR ((bf16_t*)(ws + WS_KR))
#define XC ((float*)(ws + WS_XC))
#define PART ((float*)(ws + WS_PART))
#define SIDE ((float*)(ws + WS_SIDE))
#define KRSS ((float*)(ws + WS_KRSS))
#define X_IN ((li == 0) ? IN(0) : (const float*)OUTP)
#define C_IN ((li == 0) ? IN(2) : (const float*)XC)
#define modl MOD

__device__ __forceinline__ void p0_work(const KArgs ka, unsigned char* const ws, const int wl, const int pb, const int npb, const int tid) {
    const int lane = tid & 63, wave = __builtin_amdgcn_readfirstlane(tid >> 6);
    const int gw_ = pb * 8 + wave, ngw_ = npb * 8, gt_ = pb * 512 + tid, ngt_ = npb * 512;
    LAS unsigned char* ldsl = (LAS unsigned char*)lds;
    const float* wmod = IN(6) + (size_t)wl * DM * MODW; const float* bmod = IN(7) + (size_t)wl * MODW;
    float* sl = (float*)lds; float* red = sl + 5 * DM;
    if (pb < 192) {
        for (int i = tid; i < 5 * DM; i += 512) { const int r = i >> 11, k = i & 2047; const float cv = (r < 4) ? IN(1)[r * DM + k] : IN(3)[k]; sl[i] = cv / (1.f + __expf(-cv)); }
        __syncthreads();
        for (int item = pb; item < 192; item += npb) {
            const int j0 = item * 64, cq = tid & 15, kg = tid >> 4;
            f32x4 ac[5];
#pragma unroll
            for (int r = 0; r < 5; ++r) ac[r] = (f32x4){0.f, 0.f, 0.f, 0.f};
            const float* wp = wmod + (size_t)(kg * 64) * MODW + j0 + cq * 4;
#pragma unroll 16
            for (int kk = 0; kk < 64; ++kk) { const f32x4 w = *(const f32x4*)(wp + (size_t)kk * MODW); const int k = kg * 64 + kk;
#pragma unroll
                for (int r = 0; r < 5; ++r) ac[r] = ac[r] + w * sl[r * DM + k]; }
#pragma unroll
            for (int r = 0; r < 5; ++r) *(f32x4*)(red + (kg * 5 + r) * 64 + cq * 4) = ac[r];
            __syncthreads();
            if (tid < 320) { const int r = tid >> 6, col = tid & 63; float s = 0.f;
                for (int g2 = 0; g2 < 32; ++g2) s += red[(g2 * 5 + r) * 64 + col];
                MOD[(size_t)r * MODW + j0 + col] = s + bmod[j0 + col]; }
            __syncthreads();
        }
    }
    __syncthreads();
    LAS float* scr = (LAS float*)(ldsl + wave * 16384);
    constexpr int I_IN = 32 * (IN_COLS / 32), I_POOL = 4 * 8, I_UQ = 8 * 96, I_UKV = 8 * 128, I_BA = 16 * 64, I_BC = 32 * 64, I_OUT = 32 * 64, I_UP = 32 * (2 * DFF / 32), I_DN = (DFF / 64) * 64;
    constexpr int NITEMS = I_IN + 4 * I_POOL + I_UQ + I_UKV + 2 * I_BA + I_BC + I_OUT + I_UP + I_DN;
    const int NOPAD = 1 << 30;
    for (int it = gw_; it < NITEMS; it += ngw_) {
        int r = it;
        if (r < I_IN) { transpose_item(IN(8) + (size_t)wl * DM * IN_COLS, DM, IN_COLS, WIN, 0, OFF_G, Z1C - OFF_G, scr, r, lane); continue; } r -= I_IN;
        if (r < 4 * I_POOL) { const int g4 = r / I_POOL; transpose_item(IN(9) + (size_t)(wl * 4 + g4) * 65536, 256, 256, WPOOL, g4 * 256, NOPAD, 0, scr, r % I_POOL, lane); continue; } r -= 4 * I_POOL;
        if (r < I_UQ) { const int n0 = 32 * (r % 96); transpose_item(IN(13) + (size_t)wl * 512 * 3072, 512, 3072, WUQ, 64 * (n0 / 192), NOPAD, 0, scr, r, lane); continue; } r -= I_UQ;
        if (r < I_UKV) { transpose_item(IN(15) + (size_t)wl * 512 * 4096, 512, 4096, WUKV, 0, NOPAD, 0, scr, r, lane); continue; } r -= I_UKV;
        if (r < I_BA) { transpose_item(IN(18) + (size_t)wl * 1024 * 2048, 1024, 2048, WBA, 0, NOPAD, 0, scr, r, lane); continue; } r -= I_BA;
        if (r < I_BA) { transpose_item(IN(19) + (size_t)wl * 1024 * 2048, 1024, 2048, WBB, 0, NOPAD, 0, scr, r, lane); continue; } r -= I_BA;
        if (r < I_BC) { transpose_item(IN(20) + (size_t)wl * 2048 * 2048, 2048, 2048, WBC, 0, NOPAD, 0, scr, r, lane); continue; } r -= I_BC;
        if (r < I_OUT) { transpose_item(IN(21) + (size_t)wl * 2048 * 2048, 2048, 2048, WOUT, 0, NOPAD, 0, scr, r, lane); continue; } r -= I_OUT;
        if (r < I_UP) { const int n0 = 32 * (r % (2 * DFF / 32)); const bool isv = n0 >= DFF; const int cu = isv ? n0 - DFF : n0;
            const int nd = 256 * (cu >> 7) + (isv ? 128 : 0) + (cu & 127);
            transpose_item(IN(22) + (size_t)wl * DM * 2 * DFF, DM, 2 * DFF, WUP, nd - n0, NOPAD, 0, scr, r, lane); continue; } r -= I_UP;
        transpose_item(IN(24) + (size_t)wl * DFF * DM, DFF, DM, WDN, 0, NOPAD, 0, scr, r, lane);
    }
    { const int nz = 16 * 64 * 512 * 2 / 16;
      for (int i = gt_; i < nz; i += ngt_) { const int hh = i >> 12, rem = i & 4095; ((u32x4*)(WUQ + ((size_t)hh * 256 + 192) * 512))[rem] = (u32x4){0u, 0u, 0u, 0u}; } }
    { u32x4* zp = (u32x4*)(WIN + (size_t)OFF_G * DM); const int nz = (Z1C - OFF_G) * DM * 2 / 16;
      for (int i = gt_; i < nz; i += ngt_) zp[i] = (u32x4){0u, 0u, 0u, 0u}; }
    __syncthreads();
}

template <int LI> __device__ __forceinline__ void layer_body(Ctx& cx) {
    constexpr int li = LI; constexpr int wl = LI; constexpr bool last = (LI == 1);
    const KArgs ka0 = cx.ka0; const int cx_wave = cx.wave;
    LAS unsigned char* ldsl = (LAS unsigned char*)lds;
    volatile LAS unsigned* bst = (volatile LAS unsigned*)(ldsl + LDS_STAGE);

        const int M_all = MT, M_lat = last ? ML : MT;

        if constexpr (LI == 0) {
        PH_BEGIN(0)
        p0_work(ka, ws, 0, bid, G, tid);
        PH_END(0)
        }

#define NORM_PHASE(XLAT, XCTX, GPTR, CH, NROWS, NPART, WRITEXC) do { \
            for (int row = gw; row < (NROWS); row += NGW) { \
                const bool lat = row < ML; const float* xr = lat ? (XLAT) + (size_t)row * DM : (XCTX) + (size_t)(row - ML) * DM; const int rr = lat ? (row >> 11) : 4; \
                f32x4 v[8]; float ss = 0.f; \
                const float* mp = modl + (size_t)rr * MODW; f32x4 pg[8], psh[8], psc[8]; \
                _Pragma("unroll") for (int j = 0; j < 8; ++j) v[j] = ((const f32x4*)xr)[lane + 64 * j]; \
                _Pragma("unroll") for (int j = 0; j < 8; ++j) { const int col = (lane + 64 * j) * 4; pg[j] = *(const f32x4*)((GPTR) + col); psh[j] = *(const f32x4*)(mp + (CH) * DM + col); psc[j] = *(const f32x4*)(mp + ((CH) + 1) * DM + col); } \
                _Pragma("unroll") for (int j = 0; j < 8; ++j) ss += (v[j].x * v[j].x + v[j].y * v[j].y) + (v[j].z * v[j].z + v[j].w * v[j].w); \
                if (!lat && (NPART) > 0) { ss = 0.f; for (int s_ = 0; s_ < (NPART); ++s_) { const f32x4* pp = (const f32x4*)(PART + ((size_t)s_ * MC + (row - ML)) * DM); \
                        _Pragma("unroll") for (int j = 0; j < 8; ++j) v[j] = v[j] + pp[lane + 64 * j]; } \
                    _Pragma("unroll") for (int j = 0; j < 8; ++j) ss += (v[j].x * v[j].x + v[j].y * v[j].y) + (v[j].z * v[j].z + v[j].w * v[j].w); \
                    if (WRITEXC) { _Pragma("unroll") for (int j = 0; j < 8; ++j) ((f32x4*)(XC + (size_t)(row - ML) * DM))[lane + 64 * j] = v[j]; } } \
                ss = wave_sum(ss); const float rstd = rsqrtf(ss * (1.f / DM) + EPS); \
                _Pragma("unroll") for (int j = 0; j < 8; ++j) { const int col = (lane + 64 * j) * 4; \
                    const f32x4 y = (v[j] * rstd) * pg[j]; const f32x4 hh = y * (psc[j] + 1.f) + psh[j]; \
                    u32x2 w; w.x = cvt_pk_bf16(hh.x, hh.y); w.y = cvt_pk_bf16(hh.z, hh.w); *(u32x2*)(H + (size_t)row * DM + col) = w; } \
            } } while (0)

        PH_BEGIN(1)
        NORM_PHASE(X_IN, C_IN, IN(4) + (size_t)li * DM, 0, M_all, (li == 0 ? 0 : 4), false);
        PH_END(last && 0)

        PH_BEGIN(2)
        {
            pg8::SchedOne S{H, WIN, M_lat / 256, ZP / 256, DM / 64, DM, DM, 0, G, bid, (M_all - M_lat) / 256, 18, 3};
            pg8::EpiStore E{Z1, nullptr, nullptr, Z1C, 0, 0, nullptr, Z1C / 256, Z1C / 256, GB, GC};
            pg8::gemm_stream(ldsl, S, E, cx_wave);
        }
        PH_END(last && 0)

        PH_BEGIN(3)
        {
            const float* convw = IN(11) + (size_t)li * 3 * 1024; const float* qlg = IN(12) + (size_t)li * 512; const float* kvlg = IN(14) + (size_t)li * 512;
            for (int row = gw; row < M_all; row += NGW) {
                const bool lat = row < ML; const int pos = lat ? (row & (SEQ - 1)) : ((row - ML) & (CTXL - 1)); const int L = lat ? SEQ : CTXL;
                const bf16_t* zr = Z1 + (size_t)row * Z1C;
                const bool need_full = lat || !last;
                const u32x4 z4 = (u32x4){0u, 0u, 0u, 0u};
                u32x4 wv[2][16], cw[2], gbw[2], gcw[2][3], xw[2][3], qw = z4;
                const u32x4 kw = *(const u32x4*)(zr + 4608 + lane * 8); const bf16_t krb = zr[5120 + lane];
                if (need_full) {
#pragma unroll
                    for (int ch = 0; ch < 2; ++ch) { const int col = ch * 512 + lane * 8, hw = 1 << (col >> 8);
#pragma unroll
                        for (int i = 0; i < 16; ++i) { const int sidx = pos - hw + i; const bool ok = (i < 2 * hw) && sidx >= 0 && sidx < L;
                            wv[ch][i] = ok ? *(const u32x4*)(Z1 + (size_t)(row - pos + sidx) * Z1C + col) : z4; }
                        cw[ch] = *(const u32x4*)(zr + col); gbw[ch] = *(const u32x4*)(zr + 1024 + col);
#pragma unroll
                        for (int d = 0; d < 3; ++d) { const int p2 = pos + d - 1; const bool ok = p2 >= 0 && p2 < L;
                            gcw[ch][d] = ok ? *(const u32x4*)(zr + (ptrdiff_t)(d - 1) * Z1C + 2048 + col) : z4; xw[ch][d] = ok ? *(const u32x4*)(zr + (ptrdiff_t)(d - 1) * Z1C + 3072 + col) : z4; } }
                    qw = *(const u32x4*)(zr + 4096 + lane * 8);
#pragma unroll
                    for (int ch = 0; ch < 2; ++ch) { const int col = ch * 512 + lane * 8, hw = 1 << (col >> 8);
                        const int lo_ = max(pos - hw, 0), hi_ = min(pos + hw, L);
                        float s[8];
#pragma unroll
                        for (int e = 0; e < 8; ++e) s[e] = 0.f;
#pragma unroll
                        for (int i = 0; i < 16; ++i) { float f[8]; unpack8(wv[ch][i], f);
#pragma unroll
                            for (int e = 0; e < 8; ++e) s[e] += f[e]; }
                        const float cnt = (float)(hi_ - lo_);
                        float cf[8]; unpack8(cw[ch], cf);
#pragma unroll
                        for (int e = 0; e < 8; ++e) s[e] = s[e] / cnt - cf[e];
                        *(u32x4*)(POOLED + (size_t)row * 1024 + col) = pack8(s); }
#pragma unroll
                    for (int ch = 0; ch < 2; ++ch) { const int col = ch * 512 + lane * 8;
                        float gb[8], pp[3][8];
                        unpack8(gbw[ch], gb);
#pragma unroll
                        for (int d = 0; d < 3; ++d) { float t0[8], t1[8]; unpack8(gcw[ch][d], t0); unpack8(xw[ch][d], t1);
#pragma unroll
                            for (int e = 0; e < 8; ++e) pp[d][e] = t0[e] * t1[e]; }
                        float o8[8];
#pragma unroll
                        for (int e = 0; e < 8; ++e) { const float w0 = convw[col + e], w1 = convw[1024 + col + e], w2 = convw[2048 + col + e];
                            o8[e] = gb[e] * ((pp[0][e] * w0 + pp[1][e] * w1) + pp[2][e] * w2); }
                        *(u32x4*)(U + (size_t)row * 1024 + col) = pack8(o8); }
                    { float q[8]; unpack8(qw, q); float ss = 0.f;
#pragma unroll
                      for (int e = 0; e < 8; ++e) ss += q[e] * q[e];
                      ss = wave_sum(ss); const float rstd = rsqrtf(ss * (1.f / 512.f) + EPS);
#pragma unroll
                      for (int e = 0; e < 8; ++e) q[e] = q[e] * rstd * qlg[lane * 8 + e];
                      *(u32x4*)(CQ + (size_t)row * 512 + lane * 8) = pack8(q); }
                }
                { float q[8]; unpack8(kw, q); float ss = 0.f;
#pragma unroll
                  for (int e = 0; e < 8; ++e) ss += q[e] * q[e];
                  ss = wave_sum(ss); const float rstd = rsqrtf(ss * (1.f / 512.f) + EPS);
#pragma unroll
                  for (int e = 0; e < 8; ++e) q[e] = q[e] * rstd * kvlg[lane * 8 + e];
                  *(u32x4*)(CKV + (size_t)row * 512 + lane * 8) = pack8(q);
                  KR[(size_t)row * 64 + lane] = krb; const float krf = bf2f(krb); const float kss = wave_sum(krf * krf); if (lane == 0) KRSS[row] = kss; }
            }
        }
        PH_END(last && 0)

        PH_BEGIN(4)
        {
            pg8::SchedP4 S{ws, ws + (size_t)wl * WSET, M_all / 256, M_lat / 256, G, bid};
            pg8::EpiHeads E{ws, IN(16) + (size_t)li * 192, IN(17) + (size_t)li * 192, IN(10) + (size_t)li * 1024, (LAS float*)(ldsl + LDS_EDGE)};
            pg8::gemm_stream(ldsl, S, E, cx_wave);
        }
        PH_END(last && 0)

        PH_BEGIN(5)
        {
            for (int uidx = bid; uidx < 512; uidx += G) { const int i = uidx >> 8, b8 = uidx & 255, x = b8 & 7, j = b8 >> 3; const int bh = i * 32 + x * 4 + (j >> 3), qb = j & 7, b = bh >> 4, h = bh & 15;
                att::attn_unit(QN + ((size_t)bh * SEQ + qb * 256) * 192, KN + (size_t)bh * SKV * 192, VN + (size_t)bh * SKV * 128,
                               OB + ((size_t)b * SEQ + qb * 256) * DM + h * 128, DM, SKV, (char*)lds, cx_wave); }
            if (!last) {
                for (int uidx = bid; uidx < 64; uidx += G) { const int bh = uidx, b = bh >> 4, h = bh & 15;
                    att::attn_unit(QNC + (size_t)bh * CTXL * 192, KN + ((size_t)bh * SKV + SEQ) * 192, VN + ((size_t)bh * SKV + SEQ) * 128,
                                   OB + ((size_t)ML + b * CTXL) * DM + h * 128, DM, CTXL, (char*)lds, cx_wave); }
            }
        }
        PH_END(last && 0)

        PH_BEGIN(6)
        {
            pg8::SchedChain3 S{MA, U, OB, WBA, WBB, WBC, 16, 16, 32, 1024, 1024, 2048, M_lat / 256, DM / 256, G, bid};
            pg8::EpiChainGate E{GB, GC, MERGED, DM};
            pg8::gemm_stream(ldsl, S, E, cx_wave);
            if constexpr (LI == 0) {
                const int nt2 = (MT / 256) * (DM / 256) - G; int pb = bid, npb = G;
                if (nt2 > 0 && nt2 < G) { pb = bid - nt2; npb = G - nt2; }
                if (pb >= 0) p0_work(ka, ws, 1, pb, npb, tid);
            }
        }
        PH_END(last && 0)

        PH_BEGIN(7)
        {
            pg8::SchedRes S{MERGED, WOUT, ML / 256, last ? 0 : MC / 256, DM / 256, DM / 64, 8, DM, G, bid};
            pg8::EpiRes E{X_IN, OUTP, PART, modl + 2 * DM};
            pg8::gemm_stream(ldsl, S, E, cx_wave);
        }
        PH_END(last && 0)

        PH_BEGIN(8)
        NORM_PHASE(OUTP, C_IN, IN(5) + (size_t)li * DM, 3, M_lat, 8, true);
        PH_END(last && 0)

        PH_BEGIN(9)
        {
            pg8::SchedOne S{H, WUP, M_lat / 256, 2 * DFF / 256, DM / 64, DM, DM, 0, G, bid, 0, 0, 1};
            pg8::EpiFfn E{FB, IN(23) + (size_t)li * 3 * DFF, SIDE, (LAS float*)(ldsl + LDS_EDGE)};
            pg8::gemm_stream(ldsl, S, E, cx_wave);
        }
        PH_END(last && 0)

        PH_BEGIN(10)
        {
            pg8::SchedRes S{FB, WDN, ML / 256, last ? 0 : MC / 256, DM / 256, DFF / 64, 4, DFF, G, bid};
            { const float* fc = IN(23) + (size_t)li * 3 * DFF; pg8::UnitD uu;
              for (int i = 0; S.next(i, uu); ++i) { if (uu.job != 0) continue; const int pm = uu.pm;
                for (int task = tid; task < 2 * (DFF / 8); task += 512) { const int which = task / (DFF / 8), col = (task % (DFF / 8)) * 8;
                    if (which == 0 ? ((pm & 7) == 0) : ((pm & 7) == 7)) continue;
                    const float* sp = SIDE + (size_t)pm * 6 * DFF + col;
                    const float* pp = which == 0 ? sp - (size_t)6 * DFF + (size_t)3 * DFF : sp + (size_t)2 * DFF;
                    const float* cp = which == 0 ? sp : sp + (size_t)3 * DFF;
                    const float* np = which == 0 ? sp + (size_t)DFF : sp + (size_t)6 * DFF;
                    const float* vp = which == 0 ? sp + (size_t)4 * DFF : sp + (size_t)5 * DFF;
                    float o8[8];
#pragma unroll
                    for (int hq = 0; hq < 2; ++hq) { const f32x4 a0 = *(const f32x4*)(pp + 4 * hq), a1 = *(const f32x4*)(cp + 4 * hq), a2 = *(const f32x4*)(np + 4 * hq), vv = *(const f32x4*)(vp + 4 * hq);
                        const f32x4 w0 = *(const f32x4*)(fc + col + 4 * hq), w1 = *(const f32x4*)(fc + DFF + col + 4 * hq), w2 = *(const f32x4*)(fc + 2 * DFF + col + 4 * hq);
#pragma unroll
                        for (int q = 0; q < 4; ++q) { const float cv = (a0[q] * w0[q] + a1[q] * w1[q]) + a2[q] * w2[q]; o8[hq * 4 + q] = cv * sigmoidf_(cv) * vv[q]; } }
                    *(u32x4*)(FB + ((size_t)pm * 256 + (which == 0 ? 0 : 255)) * DFF + col) = pack8(o8); } }
              asm volatile("s_waitcnt vmcnt(0)" ::: "memory"); __syncthreads(); }
            pg8::EpiRes E{OUTP, OUTP, PART, modl + 5 * DM};
            pg8::gemm_stream(ldsl, S, E, cx_wave);
        }
        PH_END(last && 1)

}
#undef PH_BEGIN
#undef PH_END

__global__ void __launch_bounds__(512, 2) mega(Args a) {
    Ctx cx;
    cx.ka0 = (KArgs)__builtin_amdgcn_kernarg_segment_ptr();
    cx.wave = __builtin_amdgcn_readfirstlane((int)threadIdx.x >> 6);
    { volatile LAS unsigned* bst = (volatile LAS unsigned*)((LAS unsigned char*)lds + LDS_STAGE);
      const int t0 = threadIdx.x;
      if (t0 < 2) bst[t0] = 0u;
      __syncthreads();
      xcd_barrier_post((unsigned*)(a.ws + WS_BAR), t0);
      if (a.flag < 0) cg::this_grid().sync(); }
    layer_body<0>(cx);
    layer_body<1>(cx);
}


extern "C" void kernel_launch(void* const* d_in, const int* in_sizes, int n_in, void* d_out, int out_size, void* d_ws, size_t ws_size, hipStream_t stream) {
    static int grid = 0;
    if (grid == 0) {
        if (n_in != 25 || out_size != ML * DM || ws_size < WS_END) { fprintf(stderr, "kernel_launch: unexpected shapes: n_in %d out %d ws %zu (need %zu)\n", n_in, out_size, ws_size, (size_t)WS_END); grid = -1; return; }
        int dev = 0, cus = 0, per_cu = 0;
        hipGetDevice(&dev); hipDeviceGetAttribute(&cus, hipDeviceAttributeMultiprocessorCount, dev);
        if (hipFuncSetAttribute((const void*)mega, hipFuncAttributeMaxDynamicSharedMemorySize, LDS_BYTES) != hipSuccess) { fprintf(stderr, "kernel_launch: hipFuncSetAttribute failed\n"); grid = -1; return; }
        if (hipOccupancyMaxActiveBlocksPerMultiprocessor(&per_cu, (const void*)mega, 512, LDS_BYTES) != hipSuccess || per_cu < 1) { fprintf(stderr, "kernel_launch: occupancy query gave %d\n", per_cu); per_cu = 1; }
        (void)hipGetLastError();
        grid = cus * 1;
        fprintf(stderr, "kernel_launch: cus %d per_cu %d grid %d ws %zu need %zu\n", cus, per_cu, grid, ws_size, (size_t)WS_END);
    }
    if (grid < 0) return;
    Args a{};
    for (int i = 0; i < 25; ++i) a.in[i] = (const float*)d_in[i];
    a.out = (float*)d_out; a.ws = (unsigned char*)d_ws;
    if (hipMemsetAsync((char*)d_ws + WS_BAR, 0, BAR_BYTES, stream) != hipSuccess) { fprintf(stderr, "kernel_launch: memset of barrier words failed\n"); return; }
    a.flag = 0; a.pad = 0;
    void* args[] = {&a};
    hipError_t e = hipLaunchCooperativeKernel((const void*)mega, dim3(grid), dim3(512), args, LDS_BYTES, stream);
    if (e != hipSuccess) fprintf(stderr, "kernel_launch: cooperative launch failed: %s (grid %d)\n", hipGetErrorString(e), grid);
}
```

```cpp
#include <hip/hip_runtime.h>
#include <hip/hip_cooperative_groups.h>
#include <cstdio>
#include <cstdint>
namespace cg = cooperative_groups;

#define LAS __attribute__((address_space(3)))
typedef unsigned short bf16_t;
typedef short bf16x8 __attribute__((ext_vector_type(8)));
typedef short s16x4 __attribute__((ext_vector_type(4)));
typedef float f32x4 __attribute__((ext_vector_type(4)));
typedef float f32x16 __attribute__((ext_vector_type(16)));
typedef unsigned u32x4 __attribute__((ext_vector_type(4)));
typedef unsigned u32x2 __attribute__((ext_vector_type(2)));

constexpr int DM = 2048, NBATCH = 4, SEQ = 2048, CTXL = 256, NH = 16;
constexpr int ML = NBATCH * SEQ, MC = NBATCH * CTXL, MT = ML + MC;
constexpr int IN_COLS = 11328, OFF_G = 5184;
constexpr int Z1C = 5376, GC = 6144, ZP = Z1C + GC;
constexpr int DFF = 5632, SKV = SEQ + CTXL;
constexpr int MODW = 6 * DM;
constexpr float EPS = 1e-6f;

constexpr size_t al256(size_t x) { return (x + 255) / 256 * 256; }
constexpr size_t WS_WIN = 0;
constexpr size_t WS_WPOOL = WS_WIN + (size_t)ZP * DM * 2;
constexpr size_t WS_WUQ = WS_WPOOL + (size_t)1024 * 256 * 2;
constexpr size_t WS_WUKV = WS_WUQ + (size_t)4096 * 512 * 2;
constexpr size_t WS_WBA = WS_WUKV + (size_t)4096 * 512 * 2;
constexpr size_t WS_WBB = WS_WBA + (size_t)2048 * 1024 * 2;
constexpr size_t WS_WBC = WS_WBB + (size_t)2048 * 1024 * 2;
constexpr size_t WS_WOUT = WS_WBC + (size_t)2048 * 2048 * 2;
constexpr size_t WS_WUP = WS_WOUT + (size_t)2048 * 2048 * 2;
constexpr size_t WS_WDN = WS_WUP + (size_t)2 * DFF * DM * 2;
constexpr size_t WSET = WS_WDN + (size_t)DM * DFF * 2;
constexpr size_t WS_MOD = 2 * WSET;
constexpr size_t WS_H = WS_MOD + al256((size_t)2 * 5 * MODW * 4);
constexpr size_t WS_Z1 = WS_H + (size_t)MT * DM * 2;
constexpr size_t WS_G = WS_Z1 + (size_t)MT * Z1C * 2;
constexpr size_t WS_PCK = WS_G + (size_t)MT * GC * 2;
constexpr size_t WS_U = WS_PCK + (size_t)MT * 2048 * 2;
constexpr size_t WS_MA = WS_U + (size_t)MT * 1024 * 2;
constexpr size_t WS_QK = WS_MA + (size_t)MT * 1024 * 2;
constexpr size_t WS_VN = WS_QK + (size_t)2 * 64 * SKV * 192 * 2;
constexpr size_t WS_KR = WS_VN + (size_t)64 * SKV * 128 * 2;
constexpr size_t WS_XC = WS_KR + (size_t)MT * 64 * 2;
constexpr size_t WS_PART = WS_XC + (size_t)MC * DM * 4;
constexpr size_t WS_SIDE = WS_PART + (size_t)8 * MC * DM * 4;
constexpr size_t WS_KRSS = WS_SIDE + (size_t)36 * 6 * DFF * 4;
constexpr size_t WS_BAR = WS_KRSS + al256((size_t)MT * 4);
constexpr size_t BAR_BYTES = 16384;
constexpr size_t WS_END = WS_BAR + BAR_BYTES;
static_assert((size_t)MT * 2 * DFF * 2 <= (size_t)MT * ZP * 2, "UV fits Z");
static_assert((size_t)MT * DFF * 2 <= (size_t)2 * 64 * SKV * 192 * 2, "F fits QK");
static_assert((size_t)MT * DM * 4 <= (size_t)2 * 64 * SKV * 192 * 2, "TMP fits QK");

static_assert(WS_END <= (size_t)871717888, "workspace must fit the guaranteed size (sum of the inputs)");
constexpr int LDS_STAGE = 131072;
constexpr int LDS_EDGE = LDS_STAGE + 256;
constexpr int LDS_BYTES = LDS_EDGE + 4096;

__device__ __forceinline__ int lane_id_() { int l; asm volatile("v_mbcnt_lo_u32_b32 %0, -1, 0\n\tv_mbcnt_hi_u32_b32 %0, -1, %0" : "=v"(l)); return l; }
__device__ __forceinline__ float shx(float v, int m) { return __int_as_float(__builtin_amdgcn_ds_bpermute((lane_id_() ^ m) << 2, __float_as_int(v))); }
#define TID_() (cx_wave * 64 + lane_id_())
__device__ __forceinline__ unsigned cvt_pk_bf16(float lo, float hi) { unsigned r; asm volatile("v_cvt_pk_bf16_f32 %0, %1, %2" : "=v"(r) : "v"(lo), "v"(hi)); return r; }
__device__ __forceinline__ float bf_lo(unsigned w) { return __uint_as_float(w << 16); }
__device__ __forceinline__ float bf_hi(unsigned w) { return __uint_as_float(w & 0xffff0000u); }
__device__ __forceinline__ float bf2f(bf16_t b) { return __uint_as_float(((unsigned)b) << 16); }
__device__ __forceinline__ bf16_t f2bf(float f) { unsigned u = __float_as_uint(f); return (bf16_t)((u + 0x7fffu + ((u >> 16) & 1u)) >> 16); }
__device__ __forceinline__ float wave_sum(float v) {
#pragma unroll
    for (int o = 1; o < 64; o <<= 1) v += shx(v, o);
    return v;
}
__device__ __forceinline__ void unpack8(u32x4 w, float* f) {
    f[0] = bf_lo(w.x); f[1] = bf_hi(w.x); f[2] = bf_lo(w.y); f[3] = bf_hi(w.y); f[4] = bf_lo(w.z); f[5] = bf_hi(w.z); f[6] = bf_lo(w.w); f[7] = bf_hi(w.w);
}
__device__ __forceinline__ u32x4 pack8(const float* f) {
    u32x4 w; w.x = cvt_pk_bf16(f[0], f[1]); w.y = cvt_pk_bf16(f[2], f[3]); w.z = cvt_pk_bf16(f[4], f[5]); w.w = cvt_pk_bf16(f[6], f[7]); return w;
}
__device__ __forceinline__ float sigmoidf_(float x) { return __builtin_amdgcn_rcpf(1.f + __builtin_amdgcn_exp2f(-1.4426950408889634f * x)); }

namespace pg8 {
constexpr int BM = 256, BK = 64, HALF = 128, HTB = HALF * BK * 2, STAGE_BYTES = 8 * HTB, NXCD = 8, WGM = 8;
__host__ __device__ __forceinline__ int lds_byte(int r, int c) { const int st = (r >> 4) * 2 + (c >> 5), rr = r & 15, cc = c & 31, ob = rr * 64 + cc * 2; return st * 1024 + (ob ^ (((ob >> 9) & 1) << 5)); }
__host__ __device__ __forceinline__ void stage_rc(int b, int& R, int& C) { const int st = b / 1024, sb = b % 1024, swz = sb ^ (((sb >> 9) & 1) << 5); R = (st >> 1) * 16 + swz / 64; C = (st & 1) * 32 + (swz % 64) / 2; }
__host__ __device__ __forceinline__ int perm32(int rho) { const int n = rho >> 4, i = rho & 15; return 8 * (i >> 2) + 4 * n + (i & 3); }

struct UnitD { const char* A; const char* B; int lda, ldb, nt, pm, pn, job, keep; };

__device__ __forceinline__ void map_tile(int wgid, int nM, int nN, int& pm, int& pn) {
    const int nwg = nM * nN;
    { const int q = nwg / NXCD, r = nwg % NXCD, xcd = wgid % NXCD, off = wgid / NXCD; wgid = (xcd < r ? xcd * (q + 1) : r * (q + 1) + (xcd - r) * q) + off; }
    const int nig = WGM * nN, gid = wgid / nig, fm = gid * WGM, gsz = (nM - fm) < WGM ? (nM - fm) : WGM;
    pm = fm + ((wgid % nig) % gsz); pn = (wgid % nig) / gsz;
}

template <class Sched, class Epi>
__device__ __forceinline__ void gemm_stream(LAS unsigned char* lds, const Sched& S, const Epi& E, const int cx_wave) {
    int tid_l = TID_(); asm volatile("" : "+v"(tid_l));
    const int tid = tid_l, wid = __builtin_amdgcn_readfirstlane(tid >> 6), lane = tid & 63, wr = wid >> 2, wc = wid & 3, fr = lane & 15, fq = lane >> 4;
    int R0, C0; stage_rc(tid * 16, R0, C0);
    const int Rb0 = (R0 & ~31) + perm32(R0 & 31);
    const size_t kstep = (size_t)(BK * 2);
    const unsigned ldsw = (unsigned)wid * 1024u;
    const int aoff = lds_byte(wr * 64 + fr, fq * 8), boff = lds_byte(wc * 32 + fr, fq * 8);
#define PG8_SA(b, h) (((b) * 2 + (h)) * HTB)
#define PG8_SB(b, h) ((4 + (b) * 2 + (h)) * HTB)
#define PG8_STAGE(bufoff, gbase, voff, h64) do { _Pragma("unroll") for (int _i = 0; _i < 2; ++_i) \
        __builtin_amdgcn_global_load_lds((const unsigned*)((const char*)(gbase) + (_i ? (h64) : (size_t)0) + (voff)), (LAS unsigned*)(lds + (bufoff) + ldsw + _i * 8192), 16, 0, 0); } while (0)
#define PG8_LDA(dst, b, h) do { _Pragma("unroll") for (int m = 0; m < 4; ++m) _Pragma("unroll") for (int k = 0; k < 2; ++k) dst[m][k] = *(const LAS bf16x8*)(lds + PG8_SA(b, h) + aoff + m * 2048 + k * 1024); } while (0)
#define PG8_LDB(dst, b, h) do { _Pragma("unroll") for (int n = 0; n < 2; ++n) _Pragma("unroll") for (int k = 0; k < 2; ++k) dst[n][k] = *(const LAS bf16x8*)(lds + PG8_SB(b, h) + boff + n * 2048 + k * 1024); } while (0)
#define PG8_MMA(ai, bj, At, Bt) do { __builtin_amdgcn_s_setprio(1); _Pragma("unroll") for (int m = 0; m < 4; ++m) _Pragma("unroll") for (int n = 0; n < 2; ++n) _Pragma("unroll") for (int k = 0; k < 2; ++k) \
        acc[ai][bj][m][n] = __builtin_amdgcn_mfma_f32_16x16x32_bf16(Bt[n][k], At[m][k], acc[ai][bj][m][n], 0, 0, 0); __builtin_amdgcn_s_setprio(0); } while (0)
#define PG8_WAIT_V(n) asm volatile("s_waitcnt vmcnt(" #n ")" ::: "memory")
#define PG8_WAIT_L(n) asm volatile("s_waitcnt lgkmcnt(" #n ")" ::: "memory")
#define PG8_BAR __builtin_amdgcn_s_barrier()
#define PG8_SCHED __builtin_amdgcn_sched_barrier(0)
#define PG8_VA(ld) ((unsigned)(R0 * (ld) + C0) * 2u)
#define PG8_VB(ld) ((unsigned)(Rb0 * (ld) + C0) * 2u)
    UnitD cur, nxt; int ui = 0;
    if (!S.next(0, cur)) return;
    f32x4 acc[2][2][4][2];
#pragma unroll
    for (int a = 0; a < 2; ++a)
#pragma unroll
        for (int b = 0; b < 2; ++b)
#pragma unroll
            for (int m = 0; m < 4; ++m)
#pragma unroll
                for (int n = 0; n < 2; ++n) acc[a][b][m][n] = (f32x4){0.f, 0.f, 0.f, 0.f};
    bf16x8 At[4][2], B0[2][2], B1[2][2];
    const char* cA = cur.A; const char* cB = cur.B;
    { const unsigned vAc = PG8_VA(cur.lda), vBc = PG8_VB(cur.ldb); const size_t hAc = (size_t)HALF * cur.lda * 2, hBc = (size_t)HALF * cur.ldb * 2;
      PG8_STAGE(PG8_SB(0, 0), cB, vBc, hBc / 2); PG8_STAGE(PG8_SB(0, 1), cB + hBc, vBc, hBc / 2); PG8_STAGE(PG8_SA(0, 0), cA, vAc, hAc / 2); PG8_STAGE(PG8_SA(0, 1), cA + hAc, vAc, hAc / 2);
      if (wr == 1) PG8_BAR;
      PG8_WAIT_V(2); PG8_BAR;
      PG8_STAGE(PG8_SB(1, 0), cB + kstep, vBc, hBc / 2); PG8_STAGE(PG8_SA(1, 0), cA + kstep, vAc, hAc / 2); PG8_STAGE(PG8_SB(1, 1), cB + hBc + kstep, vBc, hBc / 2);
      PG8_WAIT_V(6); PG8_BAR; }
    for (;;) {
        const bool has_next = S.next(ui + 1, nxt);
        if (!has_next) nxt = cur;
        const char* nA = nxt.A; const char* nB = nxt.B;
        const int nt = cur.nt;
        for (int t = 0; t < nt; t += 2) {
            const bool last = (t == nt - 2);
            const char* a1 = cA + (size_t)(t + 1) * kstep;
            const char* a2 = last ? nA : cA + (size_t)(t + 2) * kstep; const char* b2 = last ? nB : cB + (size_t)(t + 2) * kstep;
            const char* a3 = a2 + kstep; const char* b3 = b2 + kstep;
            const int lda2 = last ? nxt.lda : cur.lda, ldb2 = last ? nxt.ldb : cur.ldb;
            const unsigned vAc = PG8_VA(cur.lda), vA2 = PG8_VA(lda2), vB2 = PG8_VB(ldb2);
            const size_t hAc = (size_t)HALF * cur.lda * 2, hA2 = (size_t)HALF * lda2 * 2, hB2 = (size_t)HALF * ldb2 * 2;
            PG8_LDB(B0, 0, 0); PG8_LDB(B1, 0, 1); PG8_SCHED; PG8_LDA(At, 0, 0); PG8_STAGE(PG8_SA(1, 1), a1 + hAc, vAc, hAc / 2);
            PG8_WAIT_V(8); PG8_WAIT_L(0); PG8_BAR; PG8_MMA(0, 0, At, B0); PG8_MMA(0, 1, At, B1); PG8_BAR; PG8_SCHED;
            PG8_LDA(At, 0, 1); PG8_STAGE(PG8_SB(0, 0), b2, vB2, hB2 / 2); PG8_STAGE(PG8_SB(0, 1), b2 + hB2, vB2, hB2 / 2); PG8_STAGE(PG8_SA(0, 0), a2, vA2, hA2 / 2);
            PG8_WAIT_V(8); PG8_WAIT_L(0); PG8_BAR; PG8_MMA(1, 0, At, B0); PG8_MMA(1, 1, At, B1); PG8_BAR; PG8_SCHED;
            PG8_LDB(B0, 1, 0); PG8_LDB(B1, 1, 1); PG8_SCHED; PG8_LDA(At, 1, 0); PG8_STAGE(PG8_SA(0, 1), a2 + hA2, vA2, hA2 / 2);
            PG8_WAIT_V(8); PG8_WAIT_L(0); PG8_BAR; PG8_MMA(0, 0, At, B0); PG8_MMA(0, 1, At, B1); PG8_BAR; PG8_SCHED;
            PG8_LDA(At, 1, 1); PG8_STAGE(PG8_SB(1, 0), b3, vB2, hB2 / 2); PG8_STAGE(PG8_SB(1, 1), b3 + hB2, vB2, hB2 / 2); PG8_STAGE(PG8_SA(1, 0), a3, vA2, hA2 / 2);
            PG8_WAIT_V(8); PG8_WAIT_L(0); PG8_BAR; PG8_MMA(1, 0, At, B0); PG8_MMA(1, 1, At, B1); PG8_BAR; PG8_SCHED;
        }
        if (wr == 0) PG8_BAR;
        E(acc, cur, wr, wc, fr, fq);
        if (!has_next) break;
        if (!cur.keep) {
#pragma unroll
            for (int a = 0; a < 2; ++a)
#pragma unroll
                for (int b = 0; b < 2; ++b)
#pragma unroll
                    for (int m = 0; m < 4; ++m)
#pragma unroll
                        for (int n = 0; n < 2; ++n) acc[a][b][m][n] = (f32x4){0.f, 0.f, 0.f, 0.f};
        }
        cur = nxt; cA = nA; cB = nB; ++ui;
        if (wr == 1) PG8_BAR;
    }
    PG8_WAIT_V(0);
    PG8_BAR;
#undef PG8_SA
#undef PG8_SB
#undef PG8_STAGE
#undef PG8_LDA
#undef PG8_LDB
#undef PG8_MMA
#undef PG8_WAIT_V
#undef PG8_WAIT_L
#undef PG8_BAR
#undef PG8_SCHED
#undef PG8_VA
#undef PG8_VB
}

struct SchedOne {
    const bf16_t* A; const bf16_t* Bt; int nM, nN, nt, lda, ldb, a_pn_off, G, c; int nMx, pnx_lo, pnx_cnt;
    __device__ __forceinline__ bool next(int i, UnitD& u) const {
        const int L = i * G + c; int pm, pn;
        if (L < nM * nN) map_tile(L, nM, nN, pm, pn);
        else { const int Lx = L - nM * nN; if (Lx >= nMx * pnx_cnt) return false; pm = nM + Lx / pnx_cnt; pn = pnx_lo + Lx % pnx_cnt; }
        u.A = (const char*)(A + (size_t)pm * BM * lda + (size_t)pn * a_pn_off); u.B = (const char*)(Bt + (size_t)pn * BM * ldb);
        u.lda = lda; u.ldb = ldb; u.nt = nt; u.pm = pm; u.pn = pn; u.job = 0; u.keep = 0; return true;
    }
};
struct SchedThree {
    const bf16_t *A0, *A1, *A2, *B0, *B1, *B2; int nM0, nM1, nM2, nN0, nN1, nN2, nt0, nt1, nt2, lda0, lda1, lda2, ldb0, ldb1, ldb2, apn0, apn1, apn2; int G, c;
    __device__ __forceinline__ bool next(int i, UnitD& u) const {
        int L = i * G + c; const int n0 = nM0 * nN0, n1 = nM1 * nN1, n2 = nM2 * nN2;
        int pm, pn;
        if (L < n0) { map_tile(L, nM0, nN0, pm, pn); u.A = (const char*)(A0 + (size_t)pm * BM * lda0 + (size_t)pn * apn0); u.B = (const char*)(B0 + (size_t)pn * BM * ldb0); u.lda = lda0; u.ldb = ldb0; u.nt = nt0; u.job = 0; }
        else if (L < n0 + n1) { L -= n0; map_tile(L, nM1, nN1, pm, pn); u.A = (const char*)(A1 + (size_t)pm * BM * lda1 + (size_t)pn * apn1); u.B = (const char*)(B1 + (size_t)pn * BM * ldb1); u.lda = lda1; u.ldb = ldb1; u.nt = nt1; u.job = 1; }
        else if (L < n0 + n1 + n2) { L -= n0 + n1; map_tile(L, nM2, nN2, pm, pn); u.A = (const char*)(A2 + (size_t)pm * BM * lda2 + (size_t)pn * apn2); u.B = (const char*)(B2 + (size_t)pn * BM * ldb2); u.lda = lda2; u.ldb = ldb2; u.nt = nt2; u.job = 2; }
        else return false;
        u.pm = pm; u.pn = pn; u.keep = 0; return true;
    }
};
struct SchedP4 {
    unsigned char* ws; unsigned char* wsw; int nMall, nMlat, G, c;
    __device__ __forceinline__ bool next(int i, UnitD& u) const {
        int L = i * G + c; const int n0 = nMall * 16, n1 = nMlat * 16, n2 = nMlat * 4; int pm, pn;
        const bf16_t* pck = (const bf16_t*)(ws + WS_PCK);
        if (L < n0) { map_tile(L, nMall, 16, pm, pn); u.A = (const char*)(pck + (size_t)MT * 1536 + (size_t)pm * BM * 512); u.B = (const char*)((const bf16_t*)(wsw + WS_WUKV) + (size_t)pn * BM * 512); u.lda = 512; u.ldb = 512; u.nt = 8; u.job = 0; }
        else if (L < n0 + n1) { L -= n0; map_tile(L, nMlat, 16, pm, pn); u.A = (const char*)(pck + (size_t)MT * 1024 + (size_t)pm * BM * 512); u.B = (const char*)((const bf16_t*)(wsw + WS_WUQ) + (size_t)pn * BM * 512); u.lda = 512; u.ldb = 512; u.nt = 8; u.job = 1; }
        else if (L < n0 + n1 + n2) { L -= n0 + n1; map_tile(L, nMlat, 4, pm, pn); u.A = (const char*)(pck + (size_t)pm * BM * 1024 + (size_t)pn * 256); u.B = (const char*)((const bf16_t*)(wsw + WS_WPOOL) + (size_t)pn * BM * 256); u.lda = 1024; u.ldb = 256; u.nt = 4; u.job = 2; }
        else return false;
        u.pm = pm; u.pn = pn; u.keep = 0; return true;
    }
};
struct SchedChain3 {
    const bf16_t *A0, *A1, *A2, *B0, *B1, *B2; int nt0, nt1, nt2, lda0, lda1, lda2; int nM, nN, G, c;
    __device__ __forceinline__ bool next(int i, UnitD& u) const {
        const int tile = i / 3, br = i - tile * 3; const int L = tile * G + c; if (L >= nM * nN) return false;
        int pm, pn; map_tile(L, nM, nN, pm, pn);
        if (br == 0) { u.A = (const char*)(A0 + (size_t)pm * BM * lda0); u.B = (const char*)(B0 + (size_t)pn * BM * (nt0 * BK)); u.lda = lda0; u.ldb = nt0 * BK; u.nt = nt0; }
        else if (br == 1) { u.A = (const char*)(A1 + (size_t)pm * BM * lda1); u.B = (const char*)(B1 + (size_t)pn * BM * (nt1 * BK)); u.lda = lda1; u.ldb = nt1 * BK; u.nt = nt1; }
        else { u.A = (const char*)(A2 + (size_t)pm * BM * lda2); u.B = (const char*)(B2 + (size_t)pn * BM * (nt2 * BK)); u.lda = lda2; u.ldb = nt2 * BK; u.nt = nt2; }
        u.pm = pm; u.pn = pn; u.job = br; u.keep = br < 2; return true;
    }
};
struct SchedRes {
    const bf16_t* A; const bf16_t* Bt; int nMl, nMc, nN, nt, S, lda, G, c;
    __device__ __forceinline__ bool next(int i, UnitD& u) const {
        int L = i * G + c; const int nl = nMl * nN;
        if (L < nl) { int pm, pn; map_tile(L, nMl, nN, pm, pn);
            u.A = (const char*)(A + (size_t)pm * BM * lda); u.B = (const char*)(Bt + (size_t)pn * BM * lda); u.lda = lda; u.ldb = lda; u.nt = nt; u.pm = pm; u.pn = pn; u.job = 0; u.keep = 0; return true; }
        L -= nl; const int nc = nMc * nN; if (L >= nc * S) return false;
        const int s = L / nc, tl = L - s * nc; const int pm = nMl + tl / nN, pn = tl % nN; const int nts = nt / S;
        u.A = (const char*)(A + (size_t)pm * BM * lda + (size_t)s * nts * BK); u.B = (const char*)(Bt + (size_t)pn * BM * lda + (size_t)s * nts * BK);
        u.lda = lda; u.ldb = lda; u.nt = nts; u.pm = pm; u.pn = pn; u.job = 1 + s; u.keep = 0; return true;
    }
};

struct EpiStore {
    bf16_t *Oa, *Ob, *Oc; int ldca, ldcb, ldcc; const float* cs2; int sig_pn; int split_pn; bf16_t* O2; int ldc2;
    __device__ __forceinline__ void operator()(f32x4 (&acc)[2][2][4][2], const UnitD& u, int wr, int wc, int fr, int fq) const {
        const int row0 = u.pm * BM + wr * 64 + fr; const int j = u.job;
        bf16_t* base; int ld; const float* cs = nullptr; int colt = u.pn * BM;
        if (j == 0) { base = Oa; ld = ldca; } else if (j == 1) { base = Ob; ld = ldcb; } else { base = Oc; ld = ldcc; cs = cs2; }
        const bool img = u.pn >= split_pn;
        if (img) { base = O2; ld = ldc2; colt -= split_pn * BM; }
        const bool sig = u.pn >= sig_pn;
        const int col0 = colt + wc * 32 + 8 * fq, scol0 = u.pn * BM + wc * 32 + 8 * fq;
        f32x4 sv[2][2];
#pragma unroll
        for (int bj = 0; bj < 2; ++bj)
#pragma unroll
            for (int n = 0; n < 2; ++n) sv[bj][n] = cs ? *(const f32x4*)(cs + scol0 + bj * HALF + 4 * n) : (f32x4){1.f, 1.f, 1.f, 1.f};
#pragma unroll
        for (int ai = 0; ai < 2; ++ai)
#pragma unroll
            for (int m = 0; m < 4; ++m) { bf16_t* rowp = base + (size_t)(row0 + ai * HALF + m * 16) * ld + col0;
#pragma unroll
                for (int bj = 0; bj < 2; ++bj) { f32x4 v0 = acc[ai][bj][m][0] * sv[bj][0], v1 = acc[ai][bj][m][1] * sv[bj][1];
                    if (sig) {
#pragma unroll
                        for (int q = 0; q < 4; ++q) { v0[q] = sigmoidf_(v0[q]); v1[q] = sigmoidf_(v1[q]); } }
                    u32x4 w; w.x = cvt_pk_bf16(v0[0], v0[1]); w.y = cvt_pk_bf16(v0[2], v0[3]); w.z = cvt_pk_bf16(v1[0], v1[1]); w.w = cvt_pk_bf16(v1[2], v1[3]);
                    if (img) *((u32x4*)O2 + ((((size_t)u.pm * (GC / 256) + (u.pn - split_pn)) * 16 + (ai * 8 + m * 2 + bj)) * 8 + (wr * 4 + wc)) * 64 + (fq * 16 + fr)) = w;
                    else *(u32x4*)(rowp + bj * HALF) = w; } }
    }
};
struct EpiChainGate {
    const bf16_t* G; int ldg; bf16_t* O; int ld;
    __device__ __forceinline__ void operator()(f32x4 (&acc)[2][2][4][2], const UnitD& u, int wr, int wc, int fr, int fq) const {
        const int row0 = u.pm * BM + wr * 64 + fr, col0 = u.pn * BM + wc * 32 + 8 * fq; const int br = u.job;
        const u32x4* gbase = (const u32x4*)G + (((size_t)u.pm * (GC / 256) + (br * (DM / 256) + u.pn)) * 16 * 8 + (wr * 4 + wc)) * 64 + (fq * 16 + fr);
        constexpr size_t TILE4 = (size_t)(DM / 256) * 16 * 8 * 64;
#pragma unroll
        for (int ai = 0; ai < 2; ++ai) {
            u32x4 gnw[4][2], gdw[4][2];
#pragma unroll
            for (int m = 0; m < 4; ++m)
#pragma unroll
                for (int bj = 0; bj < 2; ++bj) { const u32x4* gp = gbase + (size_t)(ai * 8 + m * 2 + bj) * 512; gnw[m][bj] = *gp; gdw[m][bj] = (br < 2) ? *(gp + TILE4) : (u32x4){0u, 0u, 0u, 0u}; }
#pragma unroll
            for (int m = 0; m < 4; ++m) { const size_t row = (size_t)(row0 + ai * HALF + m * 16);
#pragma unroll
                for (int bj = 0; bj < 2; ++bj) { const int col = col0 + bj * HALF;
                    float gn[8]; unpack8(gnw[m][bj], gn);
                    float f[8];
                    if (br < 2) { float gd[8]; unpack8(gdw[m][bj], gd);
#pragma unroll
                        for (int q = 0; q < 8; ++q) f[q] = gn[q] * __builtin_amdgcn_rcpf(fmaxf(gd[q], 1e-30f)); }
                    else {
#pragma unroll
                        for (int q = 0; q < 8; ++q) f[q] = gn[q]; }
                    f32x4 v0 = acc[ai][bj][m][0] * (f32x4){f[0], f[1], f[2], f[3]}, v1 = acc[ai][bj][m][1] * (f32x4){f[4], f[5], f[6], f[7]};
                    if (br < 2) { acc[ai][bj][m][0] = v0; acc[ai][bj][m][1] = v1; }
                    else { u32x4 w; w.x = cvt_pk_bf16(v0[0], v0[1]); w.y = cvt_pk_bf16(v0[2], v0[3]); w.z = cvt_pk_bf16(v1[0], v1[1]); w.w = cvt_pk_bf16(v1[2], v1[3]);
                        *(u32x4*)(O + row * ld + col) = w; } } } }
    }
};
struct EpiRes {
    const float* in_lat; float* out_lat; float* out_ctx; const float* gate;
    __device__ __forceinline__ void operator()(f32x4 (&acc)[2][2][4][2], const UnitD& u, int wr, int wc, int fr, int fq) const {
        const bool lat = (u.job == 0);
        const int r = lat ? (u.pm >> 3) : 4;
        const int row0 = (lat ? u.pm : u.pm - ML / BM) * BM + wr * 64 + fr, col0 = u.pn * BM + wc * 32 + 8 * fq;
        const float* gp = gate + (size_t)r * MODW + col0;
        f32x4 gv[2][2];
#pragma unroll
        for (int bj = 0; bj < 2; ++bj)
#pragma unroll
            for (int n = 0; n < 2; ++n) gv[bj][n] = *(const f32x4*)(gp + bj * HALF + n * 4);
        if (lat) {
#pragma unroll
            for (int ai = 0; ai < 2; ++ai)
#pragma unroll
                for (int m = 0; m < 4; ++m) { const size_t off = (size_t)(row0 + ai * HALF + m * 16) * DM + col0;
#pragma unroll
                    for (int bj = 0; bj < 2; ++bj)
#pragma unroll
                        for (int n = 0; n < 2; ++n) { const size_t o2 = off + bj * HALF + n * 4; *(f32x4*)(out_lat + o2) = *(const f32x4*)(in_lat + o2) + gv[bj][n] * acc[ai][bj][m][n]; } }
        } else {
            float* part = out_ctx + (size_t)(u.job - 1) * MC * DM;
#pragma unroll
            for (int ai = 0; ai < 2; ++ai)
#pragma unroll
                for (int m = 0; m < 4; ++m) { const size_t off = (size_t)(row0 + ai * HALF + m * 16) * DM + col0;
#pragma unroll
                    for (int bj = 0; bj < 2; ++bj)
#pragma unroll
                        for (int n = 0; n < 2; ++n) *(f32x4*)(part + off + bj * HALF + n * 4) = gv[bj][n] * acc[ai][bj][m][n]; }
        }
    }
};

__device__ __forceinline__ float dpp_f(float v, const int ctrl_sel) {
    const int x = __float_as_int(v); int r;
    if (ctrl_sel == 0) r = __builtin_amdgcn_update_dpp(0, x, 0x111, 0xf, 0xf, true);
    else if (ctrl_sel == 1) r = __builtin_amdgcn_update_dpp(0, x, 0x101, 0xf, 0xf, true);
    else if (ctrl_sel == 2) r = __builtin_amdgcn_update_dpp(0, x, 0x121, 0xf, 0xf, true);
    else r = __builtin_amdgcn_update_dpp(0, x, 0x12F, 0xf, 0xf, true);
    return __int_as_float(r);
}
struct EpiFfn {
    bf16_t* F; const float* fc; float* side; LAS float* edge;
    __device__ __forceinline__ void operator()(f32x4 (&acc)[2][2][4][2], const UnitD& u, int wr, int wc, int fr, int fq) const {
        const int cl = wc * 32 + 8 * fq, col = u.pn * 128 + cl;
        f32x4 w0[2], w1[2], w2[2];
#pragma unroll
        for (int n = 0; n < 2; ++n) { w0[n] = *(const f32x4*)(fc + col + 4 * n); w1[n] = *(const f32x4*)(fc + DFF + col + 4 * n); w2[n] = *(const f32x4*)(fc + 2 * DFF + col + 4 * n); }
#pragma unroll
        for (int ai = 0; ai < 2; ++ai) { const int b = 2 * ai + wr;
            if (fr == 0) { *(LAS f32x4*)(edge + (b * 2 + 0) * 128 + cl) = acc[ai][0][0][0]; *(LAS f32x4*)(edge + (b * 2 + 0) * 128 + cl + 4) = acc[ai][0][0][1]; }
            if (fr == 15) { *(LAS f32x4*)(edge + (b * 2 + 1) * 128 + cl) = acc[ai][0][3][0]; *(LAS f32x4*)(edge + (b * 2 + 1) * 128 + cl + 4) = acc[ai][0][3][1]; } }
        asm volatile("s_waitcnt lgkmcnt(0)" ::: "memory"); __builtin_amdgcn_s_barrier(); asm volatile("" ::: "memory");
        const bool f0 = (fr == 0), f15 = (fr == 15);
#pragma unroll
        for (int ai = 0; ai < 2; ++ai) { const int b = 2 * ai + wr;
            f32x4 pe[2], ne[2];
#pragma unroll
            for (int n = 0; n < 2; ++n) { pe[n] = (b > 0) ? *(const LAS f32x4*)(edge + ((b - 1) * 2 + 1) * 128 + cl + 4 * n) : (f32x4){0.f, 0.f, 0.f, 0.f};
                                          ne[n] = (b < 3) ? *(const LAS f32x4*)(edge + ((b + 1) * 2 + 0) * 128 + cl + 4 * n) : (f32x4){0.f, 0.f, 0.f, 0.f}; }
#pragma unroll
            for (int m = 0; m < 4; ++m) { float o8[8];
#pragma unroll
                for (int n = 0; n < 2; ++n)
#pragma unroll
                    for (int q = 0; q < 4; ++q) {
                        const float cur = acc[ai][0][m][n][q];
                        const float shr = dpp_f(cur, 0), shl = dpp_f(cur, 1);
                        const float pv = (m > 0) ? dpp_f(acc[ai][0][m > 0 ? m - 1 : 0][n][q], 2) : pe[n][q];
                        const float nv = (m < 3) ? dpp_f(acc[ai][0][m < 3 ? m + 1 : 3][n][q], 3) : ne[n][q];
                        const float prev = f0 ? pv : shr, next = f15 ? nv : shl;
                        const float cv = (prev * w0[n][q] + cur * w1[n][q]) + next * w2[n][q];
                        o8[n * 4 + q] = cv * sigmoidf_(cv) * acc[ai][1][m][n][q]; }
                const size_t row = (size_t)u.pm * BM + ai * HALF + wr * 64 + m * 16 + fr;
                *(u32x4*)(F + row * DFF + col) = pack8(o8); } }
        if (u.pm < ML / BM) { float* sp = side + (size_t)u.pm * 6 * DFF + col;
            if (wr == 0 && fr < 2) { *(f32x4*)(sp + (size_t)fr * DFF) = acc[0][0][0][0]; *(f32x4*)(sp + (size_t)fr * DFF + 4) = acc[0][0][0][1];
                if (fr == 0) { *(f32x4*)(sp + (size_t)4 * DFF) = acc[0][1][0][0]; *(f32x4*)(sp + (size_t)4 * DFF + 4) = acc[0][1][0][1]; } }
            if (wr == 1 && fr >= 14) { *(f32x4*)(sp + (size_t)(fr - 12) * DFF) = acc[1][0][3][0]; *(f32x4*)(sp + (size_t)(fr - 12) * DFF + 4) = acc[1][0][3][1];
                if (fr == 15) { *(f32x4*)(sp + (size_t)5 * DFF) = acc[1][1][3][0]; *(f32x4*)(sp + (size_t)5 * DFF + 4) = acc[1][1][3][1]; } } }
    }
};

struct EpiHeads {
    unsigned char* ws; const float *qhg, *khg, *pscale; LAS float* rs;
    __device__ __forceinline__ void operator()(f32x4 (&acc)[2][2][4][2], const UnitD& u, int wr, int wc, int fr, int fq) const {
        bf16_t* const QNp = (bf16_t*)(ws + WS_QK); bf16_t* const QNCp = QNp + (size_t)64 * SEQ * 192; bf16_t* const KNp = QNp + (size_t)64 * SKV * 192; bf16_t* const VNp = (bf16_t*)(ws + WS_VN);
        const bf16_t* const KRp = (const bf16_t*)(ws + WS_KR); const float* const KRSSp = (const float*)(ws + WS_KRSS); bf16_t* const MAp = (bf16_t*)(ws + WS_MA);
        const int c8 = wc * 32 + 8 * fq;
        if (u.job == 2) {
            const int row0 = u.pm * BM + wr * 64 + fr, col0 = u.pn * BM + c8;
            f32x4 sv[2][2];
#pragma unroll
            for (int bj = 0; bj < 2; ++bj)
#pragma unroll
                for (int n = 0; n < 2; ++n) sv[bj][n] = *(const f32x4*)(pscale + col0 + bj * HALF + 4 * n);
#pragma unroll
            for (int ai = 0; ai < 2; ++ai)
#pragma unroll
                for (int m = 0; m < 4; ++m) { bf16_t* rowp = MAp + (size_t)(row0 + ai * HALF + m * 16) * 1024 + col0;
#pragma unroll
                    for (int bj = 0; bj < 2; ++bj) { const f32x4 v0 = acc[ai][bj][m][0] * sv[bj][0], v1 = acc[ai][bj][m][1] * sv[bj][1];
                        u32x4 w; w.x = cvt_pk_bf16(v0[0], v0[1]); w.y = cvt_pk_bf16(v0[2], v0[3]); w.z = cvt_pk_bf16(v1[0], v1[1]); w.w = cvt_pk_bf16(v1[2], v1[3]);
                        *(u32x4*)(rowp + bj * HALF) = w; } }
            return;
        }
        const bool isq = (u.job == 1); const int h = u.pn; const bool lat = u.pm < ML / BM;
        int fql = fq; asm volatile("" : "+v"(fql));
        const bool hi64 = isq && wc < 2;
#pragma unroll
        for (int ai = 0; ai < 2; ++ai)
#pragma unroll
            for (int m = 0; m < 4; ++m) { float s = 0.f;
#pragma unroll
                for (int n = 0; n < 2; ++n) { const f32x4 x = acc[ai][0][m][n]; s += (x[0] * x[0] + x[1] * x[1]) + (x[2] * x[2] + x[3] * x[3]); }
                if (hi64) {
#pragma unroll
                    for (int n = 0; n < 2; ++n) { const f32x4 x = acc[ai][1][m][n]; s += (x[0] * x[0] + x[1] * x[1]) + (x[2] * x[2] + x[3] * x[3]); } }
                s += shx(s, 16); s += shx(s, 32);
                if (fq == 0) rs[(ai * HALF + wr * 64 + m * 16 + fr) * 4 + wc] = s; }
        asm volatile("s_waitcnt lgkmcnt(0)" ::: "memory"); __builtin_amdgcn_s_barrier(); asm volatile("" ::: "memory");
        const float* hg = isq ? qhg : khg;
        const f32x4 g00 = *(const f32x4*)(hg + c8), g01 = *(const f32x4*)(hg + c8 + 4);
        constexpr float LF = 0.830482023721841f;
        const int d0 = 16 * wc + 4 * fql, c8l = wc * 32 + 8 * fql;
        const int gofs = isq ? (wc < 2 ? 128 + c8l : 0) : 128 + d0, gofs2 = isq ? (wc < 2 ? 128 + c8l + 4 : 0) : 128 + (d0 ^ 16);
        const f32x4 gx0 = *(const f32x4*)(hg + gofs), gx1 = *(const f32x4*)(hg + gofs2);
#pragma unroll
        for (int ai = 0; ai < 2; ++ai) {
            float krss[4]; u32x2 krow[4], krpw[4];
#pragma unroll
            for (int m = 0; m < 4; ++m) { const int grow = u.pm * BM + ai * HALF + wr * 64 + m * 16 + fr;
                if (!isq) { krss[m] = KRSSp[grow]; krow[m] = *(const u32x2*)(KRp + (size_t)grow * 64 + d0); krpw[m] = *(const u32x2*)(KRp + (size_t)grow * 64 + (d0 ^ 16)); }
                else { krss[m] = 0.f; krow[m] = (u32x2){0u, 0u}; krpw[m] = (u32x2){0u, 0u}; } }
#pragma unroll
            for (int m = 0; m < 4; ++m) {
                const int rl = ai * HALF + wr * 64 + m * 16 + fr, grow = u.pm * BM + rl;
                const f32x4 p4 = *(const LAS f32x4*)(rs + rl * 4); float tot = (p4[0] + p4[1]) + (p4[2] + p4[3]);
                tot += krss[m];
                const float rstd = rsqrtf(tot * (1.f / 192.f) + EPS);
                const int b = lat ? (grow >> 11) : ((grow - ML) >> 8), pos = lat ? (grow & (SEQ - 1)) : ((grow - ML) & (CTXL - 1));
                const size_t bh = (size_t)b * NH + h;
                const f32x4 v0 = acc[ai][0][m][0] * rstd * g00, v1 = acc[ai][0][m][1] * rstd * g01;
                u32x4 w; w.x = cvt_pk_bf16(v0[0], v0[1]); w.y = cvt_pk_bf16(v0[2], v0[3]); w.z = cvt_pk_bf16(v1[0], v1[1]); w.w = cvt_pk_bf16(v1[2], v1[3]);
                if (isq) {
                    bf16_t* qo = lat ? QNp + (bh * SEQ + pos) * 192 : QNCp + (bh * CTXL + pos) * 192;
                    *(u32x4*)(qo + c8) = w;
                    if (wc < 2) {
                        const float pc = (float)((wc == 0) ? (pos >> 6) : (pos & 63));
#pragma unroll
                        for (int n = 0; n < 2; ++n) { const f32x4 g1 = n ? gx1 : gx0; const f32x4 x = acc[ai][1][m][n] * rstd * g1; float o4[4];
#pragma unroll
                            for (int q = 0; q < 4; ++q) { const float pr = shx(x[q], 32);
                                float cs = 1.f, sn = 0.f;
                                if (lat) { const float ang = pc * __builtin_amdgcn_exp2f(-(float)(8 * (fql & 1) + 4 * n + q) * LF); cs = __cosf(ang); sn = __sinf(ang); }
                                o4[q] = (fq < 2) ? (x[q] * cs - pr * sn) : (pr * sn + x[q] * cs); }
                            u32x2 wq; wq.x = cvt_pk_bf16(o4[0], o4[1]); wq.y = cvt_pk_bf16(o4[2], o4[3]);
                            *(u32x2*)(qo + 128 + c8 + 4 * n) = wq; }
                    }
                } else {
                    const int kpos = lat ? pos : SEQ + pos;
                    bf16_t* ko = KNp + (bh * SKV + kpos) * 192;
                    *(u32x4*)(ko + c8) = w;
                    const f32x4 a0 = acc[ai][1][m][0], a1 = acc[ai][1][m][1];
                    u32x4 wv; wv.x = cvt_pk_bf16(a0[0], a0[1]); wv.y = cvt_pk_bf16(a0[2], a0[3]); wv.z = cvt_pk_bf16(a1[0], a1[1]); wv.w = cvt_pk_bf16(a1[2], a1[3]);
                    *(u32x4*)(VNp + (bh * SKV + kpos) * 128 + c8) = wv;
                    const u32x2 ow = krow[m], pw = krpw[m];
                    const f32x4 go = gx0, gq = gx1;
                    const float xo[4] = {bf_lo(ow.x), bf_hi(ow.x), bf_lo(ow.y), bf_hi(ow.y)}, xp[4] = {bf_lo(pw.x), bf_hi(pw.x), bf_lo(pw.y), bf_hi(pw.y)};
                    const float pc = (float)((wc < 2) ? (pos >> 6) : (pos & 63));
                    float o4[4];
#pragma unroll
                    for (int q = 0; q < 4; ++q) { const float x = xo[q] * rstd * go[q], y = xp[q] * rstd * gq[q];
                        float cs = 1.f, sn = 0.f;
                        if (lat) { const float ang = pc * __builtin_amdgcn_exp2f(-(float)(4 * fql + q) * LF); cs = __cosf(ang); sn = __sinf(ang); }
                        o4[q] = ((wc & 1) == 0) ? (x * cs - y * sn) : (y * sn + x * cs); }
                    u32x2 wk; wk.x = cvt_pk_bf16(o4[0], o4[1]); wk.y = cvt_pk_bf16(o4[2], o4[3]);
                    *(u32x2*)(ko + 128 + d0) = wk;
                }
                asm volatile("" ::: "memory"); __builtin_amdgcn_sched_barrier(0);
            }
        }
    }
};
}

namespace att {
constexpr int DQK = 192, DV = 128, KVBLK = 64;
constexpr float SCALE = 0.07216878364870322f;
constexpr float THR = 8.f;
constexpr int SHM_K = KVBLK * DQK * 2, SHM_V = KVBLK * DV * 2;
#define KSWZ(row, colB) ((row) * 384 + ((colB) ^ (((row) & 7) << 4)))
#define SBAR() __builtin_amdgcn_sched_barrier(0)
__device__ __forceinline__ int crow(int r, int hi) { return (r & 3) + 8 * (r >> 2) + 4 * hi; }
__device__ __forceinline__ void partialSM(f32x16& p0, f32x16& p1, float& m_reg, float& mn, float& alpha) {
    constexpr float C = SCALE * 1.4426950408889634f;
    float pmax = p0[0];
#pragma unroll
    for (int r = 1; r < 16; ++r) pmax = fmaxf(pmax, p0[r]);
#pragma unroll
    for (int r = 0; r < 16; ++r) pmax = fmaxf(pmax, p1[r]);
    { auto rr = __builtin_amdgcn_permlane32_swap(__float_as_uint(pmax), __float_as_uint(pmax), false, false);
      pmax = fmaxf(__uint_as_float(rr[0]), __uint_as_float(rr[1])); }
    if (__builtin_expect(__all(pmax - m_reg <= THR / SCALE), 1)) { mn = m_reg; alpha = 1.f; }
    else { mn = fmaxf(m_reg, pmax); alpha = __builtin_amdgcn_exp2f((m_reg - mn) * C); m_reg = mn; }
    const float mnC = -mn * C;
#pragma unroll
    for (int r = 0; r < 16; ++r) p0[r] = __builtin_amdgcn_exp2f(fmaf(p0[r], C, mnC));
#pragma unroll
    for (int r = 0; r < 16; ++r) p1[r] = __builtin_amdgcn_exp2f(fmaf(p1[r], C, mnC));
}
__device__ __forceinline__ void finishSM(f32x16& p0, f32x16& p1, float& l_reg, bf16x8& pa0, bf16x8& pa1, bf16x8& pa2, bf16x8& pa3) {
    float ps = 0;
#pragma unroll
    for (int r = 0; r < 16; ++r) ps += p0[r];
#pragma unroll
    for (int r = 0; r < 16; ++r) ps += p1[r];
    { auto rr = __builtin_amdgcn_permlane32_swap(__float_as_uint(ps), __float_as_uint(ps), false, false);
      ps = __uint_as_float(rr[0]) + __uint_as_float(rr[1]); }
    l_reg += ps;
#define PK4(P, BASE, OUT) do { unsigned a0 = cvt_pk_bf16(P[BASE + 0], P[BASE + 1]), a1 = cvt_pk_bf16(P[BASE + 2], P[BASE + 3]);   \
    unsigned b0 = cvt_pk_bf16(P[BASE + 4], P[BASE + 5]), b1 = cvt_pk_bf16(P[BASE + 6], P[BASE + 7]);                              \
    auto r0 = __builtin_amdgcn_permlane32_swap(a0, b0, false, false); auto r1 = __builtin_amdgcn_permlane32_swap(a1, b1, false, false); \
    u32x4 w = {r0[0], r1[0], r0[1], r1[1]}; OUT = *reinterpret_cast<bf16x8*>(&w); } while (0)
    PK4(p0, 0, pa0); PK4(p0, 8, pa1); PK4(p1, 0, pa2); PK4(p1, 8, pa3);
#undef PK4
}
__device__ __forceinline__ void qkt(f32x16& p0, f32x16& p1, const char* Ks, const bf16x8* qr, int r32, int hi) {
    p0 = f32x16{}; p1 = f32x16{};
#pragma unroll
    for (int d0 = 0; d0 < 12; ++d0) { const int cb = (d0 * 16 + hi * 8) * 2;
        bf16x8 b0 = *reinterpret_cast<const bf16x8*>(Ks + KSWZ(r32, cb));
        bf16x8 b1 = *reinterpret_cast<const bf16x8*>(Ks + KSWZ(32 + r32, cb));
        p0 = __builtin_amdgcn_mfma_f32_32x32x16_bf16(b0, qr[d0], p0, 0, 0, 0);
        p1 = __builtin_amdgcn_mfma_f32_32x32x16_bf16(b1, qr[d0], p1, 0, 0, 0); }
}
__device__ __forceinline__ int v_st(int k, int c) { const int kk = (k & ~0xC) | ((k & 4) << 1) | ((k & 8) >> 1); return ((kk >> 3) * 4 + (c >> 5)) * 512 + ((kk & 7) * 32 + (c & 31)) * 2; }
__device__ __forceinline__ int v_rd_base(int lane) { return ((lane & 3) << 3) | (((lane >> 2) & 3) << 6) | (((lane >> 4) & 1) << 5) | (((lane >> 5) & 1) << 8); }
constexpr int v_rd_off(int d0, int ks, int half) { return d0 * 512 + ks * 4096 + half * 2048; }
template <int OFF> __device__ __forceinline__ s16x4 tr_read(int vb) {
    s16x4 r; asm volatile("ds_read_b64_tr_b16 %0, %1 offset:%2" : "=&v"(r) : "v"(vb), "i"(OFF) : "memory"); return r;
}
template <int D0> __device__ __forceinline__ void pv_one(f32x16& od, int vb, bf16x8 pa0, bf16x8 pa1, bf16x8 pa2, bf16x8 pa3) {
    const s16x4 l0 = tr_read<v_rd_off(D0, 0, 0)>(vb), h0 = tr_read<v_rd_off(D0, 0, 1)>(vb), l1 = tr_read<v_rd_off(D0, 1, 0)>(vb), h1 = tr_read<v_rd_off(D0, 1, 1)>(vb);
    const s16x4 l2 = tr_read<v_rd_off(D0, 2, 0)>(vb), h2 = tr_read<v_rd_off(D0, 2, 1)>(vb), l3 = tr_read<v_rd_off(D0, 3, 0)>(vb), h3 = tr_read<v_rd_off(D0, 3, 1)>(vb);
    asm volatile("s_waitcnt lgkmcnt(0)" ::: "memory"); SBAR();
#define PKV(L, H) (bf16x8){L[0], L[1], L[2], L[3], H[0], H[1], H[2], H[3]}
    od = __builtin_amdgcn_mfma_f32_32x32x16_bf16(pa0, PKV(l0, h0), od, 0, 0, 0);
    od = __builtin_amdgcn_mfma_f32_32x32x16_bf16(pa1, PKV(l1, h1), od, 0, 0, 0);
    od = __builtin_amdgcn_mfma_f32_32x32x16_bf16(pa2, PKV(l2, h2), od, 0, 0, 0);
    od = __builtin_amdgcn_mfma_f32_32x32x16_bf16(pa3, PKV(l3, h3), od, 0, 0, 0);
#undef PKV
}
__device__ __forceinline__ void attn_unit(const bf16_t* Qb, const bf16_t* Kh, const bf16_t* Vh, bf16_t* Ob, int ldo, int seq, char* lds, const int cx_wave) {
    int tid_l = TID_(); asm volatile("" : "+v"(tid_l));
    const int tid = tid_l, wid = tid >> 6, lane = tid & 63, r32 = lane & 31, hi = lane >> 5;
    char* V_lds = lds; char* K_lds = lds + 3 * SHM_V;
    float* wsf = (float*)(lds + 3 * SHM_V + 3 * SHM_K) + wid * 64; float* li_l = wsf; float* al_l = wsf + 32;
    float m_reg = -1e30f, l_reg = 0.f; f32x16 o[4] = {}; bf16x8 qr[12];
    const bf16_t* Qw = Qb + (size_t)(wid * 32 + r32) * DQK + hi * 8;
#pragma unroll
    for (int d0 = 0; d0 < 12; ++d0) qr[d0] = *reinterpret_cast<const bf16x8*>(Qw + d0 * 16);
    const int p0 = tid, p1 = tid + 512, p2 = tid + 1024;
    const int ko0 = (p0 / 24) * DQK + (((p0 % 24) ^ ((p0 / 24) & 7)) * 8), ko1 = (p1 / 24) * DQK + (((p1 % 24) ^ ((p1 / 24) & 7)) * 8), ko2 = (p2 / 24) * DQK + (((p2 % 24) ^ ((p2 / 24) & 7)) * 8);
    const int q0 = tid, q1 = tid + 512;
    const int kk0 = ((q0 >> 7) << 3) | ((q0 >> 2) & 7), kk1 = ((q1 >> 7) << 3) | ((q1 >> 2) & 7);
    const int vk0 = (kk0 & ~0xC) | ((kk0 & 4) << 1) | ((kk0 & 8) >> 1), vk1 = (kk1 & ~0xC) | ((kk1 & 4) << 1) | ((kk1 & 8) >> 1);
    const int vo0 = vk0 * DV + ((((q0 >> 5) & 3) << 5) | ((q0 & 3) << 3)), vo1 = vk1 * DV + ((((q1 >> 5) & 3) << 5) | ((q1 & 3) << 3));
    const int vb0 = (int)(uintptr_t)V_lds + v_rd_base(lane);
    LAS char* K_ldsl = (LAS char*)(uintptr_t)(unsigned)(uintptr_t)K_lds; LAS char* V_ldsl = (LAS char*)(uintptr_t)(unsigned)(uintptr_t)V_lds;
    const unsigned kw = (unsigned)__builtin_amdgcn_readfirstlane(wid) * 1024u;
#define SLOAD(k0, rb) do { const bf16_t* kp_ = Kh + (size_t)(k0) * DQK; const bf16_t* vp_ = Vh + (size_t)(k0) * DV; \
    __builtin_amdgcn_global_load_lds((const unsigned*)(kp_ + ko0), (LAS unsigned*)(K_ldsl + (rb) * SHM_K + kw), 16, 0, 0); \
    __builtin_amdgcn_global_load_lds((const unsigned*)(kp_ + ko1), (LAS unsigned*)(K_ldsl + (rb) * SHM_K + kw + 8192), 16, 0, 0); \
    __builtin_amdgcn_global_load_lds((const unsigned*)(kp_ + ko2), (LAS unsigned*)(K_ldsl + (rb) * SHM_K + kw + 16384), 16, 0, 0); \
    __builtin_amdgcn_global_load_lds((const unsigned*)(vp_ + vo0), (LAS unsigned*)(V_ldsl + (rb) * SHM_V + kw), 16, 0, 0); \
    __builtin_amdgcn_global_load_lds((const unsigned*)(vp_ + vo1), (LAS unsigned*)(V_ldsl + (rb) * SHM_V + kw + 8192), 16, 0, 0); } while (0)
#define SWAIT() asm volatile("s_waitcnt vmcnt(0)" ::: "memory")
    const int NT = seq / KVBLK;
#define RESC(a) do { l_reg *= (a); if (__any((a) < 1.f)) { if (hi == 0) al_l[r32] = (a); asm volatile("s_waitcnt lgkmcnt(0)" ::: "memory"); \
    _Pragma("unroll") for (int d = 0; d < 4; ++d) _Pragma("unroll") for (int r = 0; r < 16; ++r) o[d][r] *= al_l[crow(r, hi)]; } } while (0)
#define PV(vbuf) do { const int vb_ = vb0 + (vbuf) * SHM_V; pv_one<0>(o[0], vb_, pa0, pa1, pa2, pa3); pv_one<1>(o[1], vb_, pa0, pa1, pa2, pa3); pv_one<2>(o[2], vb_, pa0, pa1, pa2, pa3); pv_one<3>(o[3], vb_, pa0, pa1, pa2, pa3); } while (0)
    f32x16 pA0, pA1, pB0, pB1; float mnA, mnB, alA, alB; bf16x8 pa0, pa1, pa2, pa3;
    SLOAD(0, 0); SWAIT(); __syncthreads();
    qkt(pA0, pA1, K_lds, qr, r32, hi); partialSM(pA0, pA1, m_reg, mnA, alA);
    SLOAD(KVBLK, 1); SWAIT(); __syncthreads();
    for (int j = 1; j + 1 < NT; j += 2) {
        const int kj = j % 3, kj1 = (j + 1) % 3, kj2 = (j + 2) % 3, kjm = (j + 2) % 3;
        SBAR(); qkt(pB0, pB1, K_lds + kj * SHM_K, qr, r32, hi);
        finishSM(pA0, pA1, l_reg, pa0, pa1, pa2, pa3); SBAR();
        SLOAD((j + 1) * KVBLK, kj1); SBAR();
        PV(kjm); partialSM(pB0, pB1, m_reg, mnB, alB);
        SWAIT(); __syncthreads();
        RESC(alB);
        SBAR(); qkt(pA0, pA1, K_lds + kj1 * SHM_K, qr, r32, hi);
        finishSM(pB0, pB1, l_reg, pa0, pa1, pa2, pa3); SBAR();
        SLOAD((j + 2) * KVBLK, kj2); SBAR();
        PV(kj); partialSM(pA0, pA1, m_reg, mnA, alA);
        SWAIT(); __syncthreads();
        RESC(alA);
    }
    SBAR(); qkt(pB0, pB1, K_lds + ((NT - 1) % 3) * SHM_K, qr, r32, hi);
    finishSM(pA0, pA1, l_reg, pa0, pa1, pa2, pa3); SBAR();
    PV((NT - 2) % 3); partialSM(pB0, pB1, m_reg, mnB, alB);
    RESC(alB);
    finishSM(pB0, pB1, l_reg, pa0, pa1, pa2, pa3); SBAR();
    PV((NT - 1) % 3);
#undef RESC
#undef PV
#undef SWAIT
    if (hi == 0) li_l[r32] = l_reg; asm volatile("s_waitcnt lgkmcnt(0)" ::: "memory");
    bf16_t* Ow = Ob + (size_t)(wid * 32) * ldo;
#pragma unroll
    for (int r = 0; r < 16; ++r) { const int orow = crow(r, hi); const float rl = __builtin_amdgcn_rcpf(li_l[orow]);
#pragma unroll
        for (int d0 = 0; d0 < 4; ++d0) Ow[(size_t)orow * ldo + d0 * 32 + r32] = f2bf(o[d0][r] * rl); }
    __syncthreads();
#undef SLOAD
#undef SWRITE
}
}


#define XB_TMO      128
#define XB_XCNT(j)  (256  + 64 * (j))
#define XB_XSUB(j)  (1280 + 64 * (j))
#define XB_XGEN(j)  (2304 + 64 * (j))
#define XB_TOP      3328
#define XB_TOPGEN   3392
#define XCD_BAR_WORDS 3456
#define XB_SPIN_CAP (1u << 18)
__device__ __forceinline__ unsigned xb_ld(unsigned* p)              { return __hip_atomic_load(p, __ATOMIC_RELAXED, __HIP_MEMORY_SCOPE_AGENT); }
__device__ __forceinline__ unsigned xb_add(unsigned* p, unsigned v) { return __hip_atomic_fetch_add(p, v, __ATOMIC_RELAXED, __HIP_MEMORY_SCOPE_AGENT); }
__device__ __forceinline__ unsigned xb_xcc_id() { return (unsigned)__builtin_amdgcn_s_getreg((3 << 11) | 20) & 0xFu; }
#define XB_SPIN(cond, bar) do { unsigned _sp = 0; while (cond) { __builtin_amdgcn_s_sleep(1); \
    if ((++_sp & 255u) == 0u) { if (xb_ld(&(bar)[XB_TMO])) break; if (_sp > XB_SPIN_CAP) { atomicAdd(&(bar)[XB_TMO], 1u); break; } } } } while (0)
__device__ __forceinline__ void xcd_barrier_post(unsigned* bar, int tid) { if (tid == 0) (void)xb_add(&bar[XB_XCNT(xb_xcc_id())], 1u); }
__device__ __forceinline__ void xcd_barrier_complete(unsigned* bar, unsigned x, unsigned& nloc, unsigned& nx) {
    const unsigned G = gridDim.x;
    unsigned sum, cnt, mine, sp = 0u;
    for (;;) {
        sum = 0u; cnt = 0u; mine = 0u;
#pragma unroll
        for (unsigned j = 0; j < 16; ++j) { const unsigned c = xb_ld(&bar[XB_XCNT(j)]); sum += c; cnt += (c > 0u) ? 1u : 0u; mine = (j == x) ? c : mine; }
        if (sum == G) break;
        __builtin_amdgcn_s_sleep(1);
        if ((++sp & 255u) == 0u) { if (xb_ld(&bar[XB_TMO])) break; if (sp > XB_SPIN_CAP) { atomicAdd(&bar[XB_TMO], 1u); break; } }
    }
    nloc = mine > 0u ? mine : 1u; nx = cnt > 0u ? cnt : 1u;
}
__device__ __forceinline__ void xcd_barrier(unsigned* bar, volatile LAS unsigned* st, int tid) {
    asm volatile("s_waitcnt vmcnt(0)" ::: "memory");
    __syncthreads();
    if (tid == 0) {
        const unsigned x = xb_xcc_id();
        __builtin_amdgcn_s_waitcnt(0);
        unsigned nloc = st[0], nx = st[1];
        if (nloc == 0u) { xcd_barrier_complete(bar, x, nloc, nx); st[0] = nloc; st[1] = nx; }
        const unsigned old = xb_add(&bar[XB_XSUB(x)], 1u);
        const unsigned gen = old / nloc;
        if (old + 1u == (gen + 1u) * nloc) {
            __builtin_amdgcn_fence(__ATOMIC_RELEASE, "agent");
            asm volatile("s_waitcnt vmcnt(0)" ::: "memory");
            const unsigned og = xb_add(&bar[XB_TOP], 1u);
            const unsigned tg = og / nx;
            if (og + 1u == (tg + 1u) * nx) xb_add(&bar[XB_TOPGEN], 1u);
            else XB_SPIN(xb_ld(&bar[XB_TOPGEN]) == tg, bar);
            __builtin_amdgcn_fence(__ATOMIC_ACQUIRE, "agent");
            xb_add(&bar[XB_XGEN(x)], 1u);
            asm volatile("s_waitcnt vmcnt(0)" ::: "memory");
        } else {
            XB_SPIN(xb_ld(&bar[XB_XGEN(x)]) == gen, bar);
            __builtin_amdgcn_fence(__ATOMIC_ACQUIRE, "agent");
            asm volatile("s_waitcnt vmcnt(0)" ::: "memory");
        }
    }
    __syncthreads();
}

struct Args { const float* in[25]; float* out; unsigned char* ws; int flag, pad; };

__device__ __forceinline__ void transpose_item(const float* W, int K, int N, bf16_t* WT, int row_off, int pad_from, int pad_amt, LAS float* scr, int item, int lane) {
    const int nblk = N / 32, kb = item / nblk, nb = item % nblk, k0 = 64 * kb, n0 = 32 * nb;
    const int roff = row_off + (n0 >= pad_from ? pad_amt : 0);
    float tv[32];
#pragma unroll
    for (int i = 0; i < 32; ++i) { const int kk = 2 * i + (lane >> 5); tv[i] = W[(size_t)(k0 + kk) * N + n0 + (lane & 31)]; }
#pragma unroll
    for (int i = 0; i < 32; ++i) { const int kk = 2 * i + (lane >> 5); scr[kk * 33 + (lane & 31)] = tv[i]; }
    asm volatile("s_waitcnt lgkmcnt(0)" ::: "memory");
    const int c = lane & 7;
#pragma unroll
    for (int j = 0; j < 4; ++j) { const int n = (lane >> 3) + 8 * j; const LAS float* s = scr + (8 * c) * 33 + n;
        u32x4 o; o.x = cvt_pk_bf16(s[0 * 33], s[1 * 33]); o.y = cvt_pk_bf16(s[2 * 33], s[3 * 33]); o.z = cvt_pk_bf16(s[4 * 33], s[5 * 33]); o.w = cvt_pk_bf16(s[6 * 33], s[7 * 33]);
        *(u32x4*)(WT + (size_t)(roff + n0 + n) * K + k0 + 8 * c) = o; }
    asm volatile("s_waitcnt lgkmcnt(0)" ::: "memory");
}

extern __shared__ __attribute__((aligned(16))) unsigned char lds[];
typedef __attribute__((address_space(4))) const Args* KArgs;
struct Ctx { KArgs ka0; int wave; };
#ifndef REP_MASK
#define REP_MASK 0
#endif
#ifndef SYNC_REP
#define SYNC_REP 1
#endif
#define PH_BEGIN(ID) for (int rep_ = 0; rep_ < (((REP_MASK >> (ID)) & 1) ? 2 : 1); ++rep_) { if (rep_) { KArgs kb = ka0; asm volatile("" : "+s"(kb)); xcd_barrier((unsigned*)(kb->ws + WS_BAR), bst, TID_()); } KArgs ka = ka0; asm volatile("" : "+s"(ka)); int tid = TID_(); asm volatile("" : "+v"(tid)); \
    const int G = gridDim.x, bid = blockIdx.x, NGW = G * 8, NGT = G * 512; const int lane = tid & 63, wave = __builtin_amdgcn_readfirstlane(tid >> 6); const int gw = bid * 8 + wave, gt = bid * 512 + tid; unsigned char* const ws = ka->ws; \
    (void)lane; (void)wave; (void)gw; (void)gt; (void)ws; (void)NGW; (void)NGT;
#define PH_END(LASTPH) } if (!(LASTPH)) { for (int sr_ = 0; sr_ < SYNC_REP; ++sr_) { KArgs kb = ka0; asm volatile("" : "+s"(kb)); xcd_barrier((unsigned*)(kb->ws + WS_BAR), bst, TID_()); } }
#define IN(k) (ka->in[k])
#define OUTP (ka->out)
#define WIN ((bf16_t*)(ws + WS_WIN + (size_t)wl * WSET))
#define WPOOL ((bf16_t*)(ws + WS_WPOOL + (size_t)wl * WSET))
#define WUQ ((bf16_t*)(ws + WS_WUQ + (size_t)wl * WSET))
#define WUKV ((bf16_t*)(ws + WS_WUKV + (size_t)wl * WSET))
#define WBA ((bf16_t*)(ws + WS_WBA + (size_t)wl * WSET))
#define WBB ((bf16_t*)(ws + WS_WBB + (size_t)wl * WSET))
#define WBC ((bf16_t*)(ws + WS_WBC + (size_t)wl * WSET))
#define WOUT ((bf16_t*)(ws + WS_WOUT + (size_t)wl * WSET))
#define WUP ((bf16_t*)(ws + WS_WUP + (size_t)wl * WSET))
#define WDN ((bf16_t*)(ws + WS_WDN + (size_t)wl * WSET))
#define MOD ((float*)(ws + WS_MOD) + (size_t)wl * 5 * MODW)
#define H ((bf16_t*)(ws + WS_H))
#define MERGED H
#define Z1 ((bf16_t*)(ws + WS_Z1))
#define QRAW Z1
#define UV Z1
#define GB ((bf16_t*)(ws + WS_G))
#define POOLED ((bf16_t*)(ws + WS_PCK))
#define CQ (POOLED + (size_t)MT * 1024)
#define CKV (CQ + (size_t)MT * 512)
#define OB POOLED
#define U ((bf16_t*)(ws + WS_U))
#define MA ((bf16_t*)(ws + WS_MA))
#define QN ((bf16_t*)(ws + WS_QK))
#define QNC (QN + (size_t)64 * SEQ * 192)
#define KN (QN + (size_t)64 * SKV * 192)
#define TMP ((float*)(ws + WS_QK))
#define FB ((bf16_t*)(ws + WS_QK))
#define VN ((bf16_t*)(ws + WS_VN))
#define KR ((bf16_t*)(ws + WS_KR))
#define XC ((float*)(ws + WS_XC))
#define PART ((float*)(ws + WS_PART))
#define SIDE ((float*)(ws + WS_SIDE))
#define KRSS ((float*)(ws + WS_KRSS))
#define X_IN ((li == 0) ? IN(0) : (const float*)OUTP)
#define C_IN ((li == 0) ? IN(2) : (const float*)XC)
#define modl MOD

__device__ __forceinline__ void p0_work(const KArgs ka, unsigned char* const ws, const int wl, const int pb, const int npb, const int tid) {
    const int lane = tid & 63, wave = __builtin_amdgcn_readfirstlane(tid >> 6);
    const int gw_ = pb * 8 + wave, ngw_ = npb * 8, gt_ = pb * 512 + tid, ngt_ = npb * 512;
    LAS unsigned char* ldsl = (LAS unsigned char*)lds;
    const float* wmod = IN(6) + (size_t)wl * DM * MODW; const float* bmod = IN(7) + (size_t)wl * MODW;
    float* sl = (float*)lds; float* red = sl + 5 * DM;
    if (pb < 192) {
        for (int i = tid; i < 5 * DM; i += 512) { const int r = i >> 11, k = i & 2047; const float cv = (r < 4) ? IN(1)[r * DM + k] : IN(3)[k]; sl[i] = cv / (1.f + __expf(-cv)); }
        __syncthreads();
        for (int item = pb; item < 192; item += npb) {
            const int j0 = item * 64, cq = tid & 15, kg = tid >> 4;
            f32x4 ac[5];
#pragma unroll
            for (int r = 0; r < 5; ++r) ac[r] = (f32x4){0.f, 0.f, 0.f, 0.f};
            const float* wp = wmod + (size_t)(kg * 64) * MODW + j0 + cq * 4;
#pragma unroll 16
            for (int kk = 0; kk < 64; ++kk) { const f32x4 w = *(const f32x4*)(wp + (size_t)kk * MODW); const int k = kg * 64 + kk;
#pragma unroll
                for (int r = 0; r < 5; ++r) ac[r] = ac[r] + w * sl[r * DM + k]; }
#pragma unroll
            for (int r = 0; r < 5; ++r) *(f32x4*)(red + (kg * 5 + r) * 64 + cq * 4) = ac[r];
            __syncthreads();
            if (tid < 320) { const int r = tid >> 6, col = tid & 63; float s = 0.f;
                for (int g2 = 0; g2 < 32; ++g2) s += red[(g2 * 5 + r) * 64 + col];
                MOD[(size_t)r * MODW + j0 + col] = s + bmod[j0 + col]; }
            __syncthreads();
        }
    }
    __syncthreads();
    LAS float* scr = (LAS float*)(ldsl + wave * 16384);
    constexpr int I_IN = 32 * (IN_COLS / 32), I_POOL = 4 * 8, I_UQ = 8 * 96, I_UKV = 8 * 128, I_BA = 16 * 64, I_BC = 32 * 64, I_OUT = 32 * 64, I_UP = 32 * (2 * DFF / 32), I_DN = (DFF / 64) * 64;
    constexpr int NITEMS = I_IN + 4 * I_POOL + I_UQ + I_UKV + 2 * I_BA + I_BC + I_OUT + I_UP + I_DN;
    const int NOPAD = 1 << 30;
    for (int it = gw_; it < NITEMS; it += ngw_) {
        int r = it;
        if (r < I_IN) { transpose_item(IN(8) + (size_t)wl * DM * IN_COLS, DM, IN_COLS, WIN, 0, OFF_G, Z1C - OFF_G, scr, r, lane); continue; } r -= I_IN;
        if (r < 4 * I_POOL) { const int g4 = r / I_POOL; transpose_item(IN(9) + (size_t)(wl * 4 + g4) * 65536, 256, 256, WPOOL, g4 * 256, NOPAD, 0, scr, r % I_POOL, lane); continue; } r -= 4 * I_POOL;
        if (r < I_UQ) { const int n0 = 32 * (r % 96); transpose_item(IN(13) + (size_t)wl * 512 * 3072, 512, 3072, WUQ, 64 * (n0 / 192), NOPAD, 0, scr, r, lane); continue; } r -= I_UQ;
        if (r < I_UKV) { transpose_item(IN(15) + (size_t)wl * 512 * 4096, 512, 4096, WUKV, 0, NOPAD, 0, scr, r, lane); continue; } r -= I_UKV;
        if (r < I_BA) { transpose_item(IN(18) + (size_t)wl * 1024 * 2048, 1024, 2048, WBA, 0, NOPAD, 0, scr, r, lane); continue; } r -= I_BA;
        if (r < I_BA) { transpose_item(IN(19) + (size_t)wl * 1024 * 2048, 1024, 2048, WBB, 0, NOPAD, 0, scr, r, lane); continue; } r -= I_BA;
        if (r < I_BC) { transpose_item(IN(20) + (size_t)wl * 2048 * 2048, 2048, 2048, WBC, 0, NOPAD, 0, scr, r, lane); continue; } r -= I_BC;
        if (r < I_OUT) { transpose_item(IN(21) + (size_t)wl * 2048 * 2048, 2048, 2048, WOUT, 0, NOPAD, 0, scr, r, lane); continue; } r -= I_OUT;
        if (r < I_UP) { const int n0 = 32 * (r % (2 * DFF / 32)); const bool isv = n0 >= DFF; const int cu = isv ? n0 - DFF : n0;
            const int nd = 256 * (cu >> 7) + (isv ? 128 : 0) + (cu & 127);
            transpose_item(IN(22) + (size_t)wl * DM * 2 * DFF, DM, 2 * DFF, WUP, nd - n0, NOPAD, 0, scr, r, lane); continue; } r -= I_UP;
        transpose_item(IN(24) + (size_t)wl * DFF * DM, DFF, DM, WDN, 0, NOPAD, 0, scr, r, lane);
    }
    { const int nz = 16 * 64 * 512 * 2 / 16;
      for (int i = gt_; i < nz; i += ngt_) { const int hh = i >> 12, rem = i & 4095; ((u32x4*)(WUQ + ((size_t)hh * 256 + 192) * 512))[rem] = (u32x4){0u, 0u, 0u, 0u}; } }
    { u32x4* zp = (u32x4*)(WIN + (size_t)OFF_G * DM); const int nz = (Z1C - OFF_G) * DM * 2 / 16;
      for (int i = gt_; i < nz; i += ngt_) zp[i] = (u32x4){0u, 0u, 0u, 0u}; }
    __syncthreads();
}

template <int LI> __device__ __forceinline__ void layer_body(Ctx& cx) {
    constexpr int li = LI; constexpr int wl = LI; constexpr bool last = (LI == 1);
    const KArgs ka0 = cx.ka0; const int cx_wave = cx.wave;
    LAS unsigned char* ldsl = (LAS unsigned char*)lds;
    volatile LAS unsigned* bst = (volatile LAS unsigned*)(ldsl + LDS_STAGE);

        const int M_all = MT, M_lat = last ? ML : MT;

        if constexpr (LI == 0) {
        PH_BEGIN(0)
        p0_work(ka, ws, 0, bid, G, tid);
        PH_END(0)
        }

#define NORM_PHASE(XLAT, XCTX, GPTR, CH, NROWS, NPART, WRITEXC) do { \
            for (int row = gw; row < (NROWS); row += NGW) { \
                const bool lat = row < ML; const float* xr = lat ? (XLAT) + (size_t)row * DM : (XCTX) + (size_t)(row - ML) * DM; const int rr = lat ? (row >> 11) : 4; \
                f32x4 v[8]; float ss = 0.f; \
                const float* mp = modl + (size_t)rr * MODW; f32x4 pg[8], psh[8], psc[8]; \
                _Pragma("unroll") for (int j = 0; j < 8; ++j) v[j] = ((const f32x4*)xr)[lane + 64 * j]; \
                _Pragma("unroll") for (int j = 0; j < 8; ++j) { const int col = (lane + 64 * j) * 4; pg[j] = *(const f32x4*)((GPTR) + col); psh[j] = *(const f32x4*)(mp + (CH) * DM + col); psc[j] = *(const f32x4*)(mp + ((CH) + 1) * DM + col); } \
                _Pragma("unroll") for (int j = 0; j < 8; ++j) ss += (v[j].x * v[j].x + v[j].y * v[j].y) + (v[j].z * v[j].z + v[j].w * v[j].w); \
                if (!lat && (NPART) > 0) { ss = 0.f; for (int s_ = 0; s_ < (NPART); ++s_) { const f32x4* pp = (const f32x4*)(PART + ((size_t)s_ * MC + (row - ML)) * DM); \
                        _Pragma("unroll") for (int j = 0; j < 8; ++j) v[j] = v[j] + pp[lane + 64 * j]; } \
                    _Pragma("unroll") for (int j = 0; j < 8; ++j) ss += (v[j].x * v[j].x + v[j].y * v[j].y) + (v[j].z * v[j].z + v[j].w * v[j].w); \
                    if (WRITEXC) { _Pragma("unroll") for (int j = 0; j < 8; ++j) ((f32x4*)(XC + (size_t)(row - ML) * DM))[lane + 64 * j] = v[j]; } } \
                ss = wave_sum(ss); const float rstd = rsqrtf(ss * (1.f / DM) + EPS); \
                _Pragma("unroll") for (int j = 0; j < 8; ++j) { const int col = (lane + 64 * j) * 4; \
                    const f32x4 y = (v[j] * rstd) * pg[j]; const f32x4 hh = y * (psc[j] + 1.f) + psh[j]; \
                    u32x2 w; w.x = cvt_pk_bf16(hh.x, hh.y); w.y = cvt_pk_bf16(hh.z, hh.w); *(u32x2*)(H + (size_t)row * DM + col) = w; } \
            } } while (0)

        PH_BEGIN(1)
        NORM_PHASE(X_IN, C_IN, IN(4) + (size_t)li * DM, 0, M_all, (li == 0 ? 0 : 4), false);
        PH_END(last && 0)

        PH_BEGIN(2)
        {
            pg8::SchedOne S{H, WIN, M_lat / 256, ZP / 256, DM / 64, DM, DM, 0, G, bid, (M_all - M_lat) / 256, 18, 3};
            pg8::EpiStore E{Z1, nullptr, nullptr, Z1C, 0, 0, nullptr, Z1C / 256, Z1C / 256, GB, GC};
            pg8::gemm_stream(ldsl, S, E, cx_wave);
        }
        PH_END(last && 0)

        PH_BEGIN(3)
        {
            const float* convw = IN(11) + (size_t)li * 3 * 1024; const float* qlg = IN(12) + (size_t)li * 512; const float* kvlg = IN(14) + (size_t)li * 512;
            for (int row = gw; row < M_all; row += NGW) {
                const bool lat = row < ML; const int pos = lat ? (row & (SEQ - 1)) : ((row - ML) & (CTXL - 1)); const int L = lat ? SEQ : CTXL;
                const bf16_t* zr = Z1 + (size_t)row * Z1C;
                const bool need_full = lat || !last;
                const u32x4 z4 = (u32x4){0u, 0u, 0u, 0u};
                u32x4 wv[2][16], cw[2], gbw[2], gcw[2][3], xw[2][3], qw = z4;
                const u32x4 kw = *(const u32x4*)(zr + 4608 + lane * 8); const bf16_t krb = zr[5120 + lane];
                if (need_full) {
#pragma unroll
                    for (int ch = 0; ch < 2; ++ch) { const int col = ch * 512 + lane * 8, hw = 1 << (col >> 8);
#pragma unroll
                        for (int i = 0; i < 16; ++i) { const int sidx = pos - hw + i; const bool ok = (i < 2 * hw) && sidx >= 0 && sidx < L;
                            wv[ch][i] = ok ? *(const u32x4*)(Z1 + (size_t)(row - pos + sidx) * Z1C + col) : z4; }
                        cw[ch] = *(const u32x4*)(zr + col); gbw[ch] = *(const u32x4*)(zr + 1024 + col);
#pragma unroll
                        for (int d = 0; d < 3; ++d) { const int p2 = pos + d - 1; const bool ok = p2 >= 0 && p2 < L;
                            gcw[ch][d] = ok ? *(const u32x4*)(zr + (ptrdiff_t)(d - 1) * Z1C + 2048 + col) : z4; xw[ch][d] = ok ? *(const u32x4*)(zr + (ptrdiff_t)(d - 1) * Z1C + 3072 + col) : z4; } }
                    qw = *(const u32x4*)(zr + 4096 + lane * 8);
#pragma unroll
                    for (int ch = 0; ch < 2; ++ch) { const int col = ch * 512 + lane * 8, hw = 1 << (col >> 8);
                        const int lo_ = max(pos - hw, 0), hi_ = min(pos + hw, L);
                        float s[8];
#pragma unroll
                        for (int e = 0; e < 8; ++e) s[e] = 0.f;
#pragma unroll
                        for (int i = 0; i < 16; ++i) { float f[8]; unpack8(wv[ch][i], f);
#pragma unroll
                            for (int e = 0; e < 8; ++e) s[e] += f[e]; }
                        const float cnt = (float)(hi_ - lo_);
                        float cf[8]; unpack8(cw[ch], cf);
#pragma unroll
                        for (int e = 0; e < 8; ++e) s[e] = s[e] / cnt - cf[e];
                        *(u32x4*)(POOLED + (size_t)row * 1024 + col) = pack8(s); }
#pragma unroll
                    for (int ch = 0; ch < 2; ++ch) { const int col = ch * 512 + lane * 8;
                        float gb[8], pp[3][8];
                        unpack8(gbw[ch], gb);
#pragma unroll
                        for (int d = 0; d < 3; ++d) { float t0[8], t1[8]; unpack8(gcw[ch][d], t0); unpack8(xw[ch][d], t1);
#pragma unroll
                            for (int e = 0; e < 8; ++e) pp[d][e] = t0[e] * t1[e]; }
                        float o8[8];
#pragma unroll
                        for (int e = 0; e < 8; ++e) { const float w0 = convw[col + e], w1 = convw[1024 + col + e], w2 = convw[2048 + col + e];
                            o8[e] = gb[e] * ((pp[0][e] * w0 + pp[1][e] * w1) + pp[2][e] * w2); }
                        *(u32x4*)(U + (size_t)row * 1024 + col) = pack8(o8); }
                    { float q[8]; unpack8(qw, q); float ss = 0.f;
#pragma unroll
                      for (int e = 0; e < 8; ++e) ss += q[e] * q[e];
                      ss = wave_sum(ss); const float rstd = rsqrtf(ss * (1.f / 512.f) + EPS);
#pragma unroll
                      for (int e = 0; e < 8; ++e) q[e] = q[e] * rstd * qlg[lane * 8 + e];
                      *(u32x4*)(CQ + (size_t)row * 512 + lane * 8) = pack8(q); }
                }
                { float q[8]; unpack8(kw, q); float ss = 0.f;
#pragma unroll
                  for (int e = 0; e < 8; ++e) ss += q[e] * q[e];
                  ss = wave_sum(ss); const float rstd = rsqrtf(ss * (1.f / 512.f) + EPS);
#pragma unroll
                  for (int e = 0; e < 8; ++e) q[e] = q[e] * rstd * kvlg[lane * 8 + e];
                  *(u32x4*)(CKV + (size_t)row * 512 + lane * 8) = pack8(q);
                  KR[(size_t)row * 64 + lane] = krb; const float krf = bf2f(krb); const float kss = wave_sum(krf * krf); if (lane == 0) KRSS[row] = kss; }
            }
        }
        PH_END(last && 0)

        PH_BEGIN(4)
        {
            pg8::SchedP4 S{ws, ws + (size_t)wl * WSET, M_all / 256, M_lat / 256, G, bid};
            pg8::EpiHeads E{ws, IN(16) + (size_t)li * 192, IN(17) + (size_t)li * 192, IN(10) + (size_t)li * 1024, (LAS float*)(ldsl + LDS_EDGE)};
            pg8::gemm_stream(ldsl, S, E, cx_wave);
        }
        PH_END(last && 0)

        PH_BEGIN(5)
        {
            for (int uidx = bid; uidx < 512; uidx += G) { const int i = uidx >> 8, b8 = uidx & 255, x = b8 & 7, j = b8 >> 3; const int bh = i * 32 + x * 4 + (j >> 3), qb = j & 7, b = bh >> 4, h = bh & 15;
                att::attn_unit(QN + ((size_t)bh * SEQ + qb * 256) * 192, KN + (size_t)bh * SKV * 192, VN + (size_t)bh * SKV * 128,
                               OB + ((size_t)b * SEQ + qb * 256) * DM + h * 128, DM, SKV, (char*)lds, cx_wave); }
            if (!last) {
                for (int uidx = bid; uidx < 64; uidx += G) { const int bh = uidx, b = bh >> 4, h = bh & 15;
                    att::attn_unit(QNC + (size_t)bh * CTXL * 192, KN + ((size_t)bh * SKV + SEQ) * 192, VN + ((size_t)bh * SKV + SEQ) * 128,
                                   OB + ((size_t)ML + b * CTXL) * DM + h * 128, DM, CTXL, (char*)lds, cx_wave); }
            }
        }
        PH_END(last && 0)

        PH_BEGIN(6)
        {
            pg8::SchedChain3 S{MA, U, OB, WBA, WBB, WBC, 16, 16, 32, 1024, 1024, 2048, M_lat / 256, DM / 256, G, bid};
            pg8::EpiChainGate E{GB, GC, MERGED, DM};
            pg8::gemm_stream(ldsl, S, E, cx_wave);
            if constexpr (LI == 0) {
                const int nt2 = (MT / 256) * (DM / 256) - G; int pb = bid, npb = G;
                if (nt2 > 0 && nt2 < G) { pb = bid - nt2; npb = G - nt2; }
                if (pb >= 0) p0_work(ka, ws, 1, pb, npb, tid);
            }
        }
        PH_END(last && 0)

        PH_BEGIN(7)
        {
            pg8::SchedRes S{MERGED, WOUT, ML / 256, last ? 0 : MC / 256, DM / 256, DM / 64, 8, DM, G, bid};
            pg8::EpiRes E{X_IN, OUTP, PART, modl + 2 * DM};
            pg8::gemm_stream(ldsl, S, E, cx_wave);
        }
        PH_END(last && 0)

        PH_BEGIN(8)
        NORM_PHASE(OUTP, C_IN, IN(5) + (size_t)li * DM, 3, M_lat, 8, true);
        PH_END(last && 0)

        PH_BEGIN(9)
        {
            pg8::SchedOne S{H, WUP, M_lat / 256, 2 * DFF / 256, DM / 64, DM, DM, 0, G, bid, 0, 0, 1};
            pg8::EpiFfn E{FB, IN(23) + (size_t)li * 3 * DFF, SIDE, (LAS float*)(ldsl + LDS_EDGE)};
            pg8::gemm_stream(ldsl, S, E, cx_wave);
        }
        PH_END(last && 0)

        PH_BEGIN(10)
        {
            pg8::SchedRes S{FB, WDN, ML / 256, last ? 0 : MC / 256, DM / 256, DFF / 64, 4, DFF, G, bid};
            { const float* fc = IN(23) + (size_t)li * 3 * DFF; pg8::UnitD uu;
              for (int i = 0; S.next(i, uu); ++i) { if (uu.job != 0) continue; const int pm = uu.pm;
                for (int task = tid; task < 2 * (DFF / 8); task += 512) { const int which = task / (DFF / 8), col = (task % (DFF / 8)) * 8;
                    if (which == 0 ? ((pm & 7) == 0) : ((pm & 7) == 7)) continue;
                    const float* sp = SIDE + (size_t)pm * 6 * DFF + col;
                    const float* pp = which == 0 ? sp - (size_t)6 * DFF + (size_t)3 * DFF : sp + (size_t)2 * DFF;
                    const float* cp = which == 0 ? sp : sp + (size_t)3 * DFF;
                    const float* np = which == 0 ? sp + (size_t)DFF : sp + (size_t)6 * DFF;
                    const float* vp = which == 0 ? sp + (size_t)4 * DFF : sp + (size_t)5 * DFF;
                    float o8[8];
#pragma unroll
                    for (int hq = 0; hq < 2; ++hq) { const f32x4 a0 = *(const f32x4*)(pp + 4 * hq), a1 = *(const f32x4*)(cp + 4 * hq), a2 = *(const f32x4*)(np + 4 * hq), vv = *(const f32x4*)(vp + 4 * hq);
                        const f32x4 w0 = *(const f32x4*)(fc + col + 4 * hq), w1 = *(const f32x4*)(fc + DFF + col + 4 * hq), w2 = *(const f32x4*)(fc + 2 * DFF + col + 4 * hq);
#pragma unroll
                        for (int q = 0; q < 4; ++q) { const float cv = (a0[q] * w0[q] + a1[q] * w1[q]) + a2[q] * w2[q]; o8[hq * 4 + q] = cv * sigmoidf_(cv) * vv[q]; } }
                    *(u32x4*)(FB + ((size_t)pm * 256 + (which == 0 ? 0 : 255)) * DFF + col) = pack8(o8); } }
              asm volatile("s_waitcnt vmcnt(0)" ::: "memory"); __syncthreads(); }
            pg8::EpiRes E{OUTP, OUTP, PART, modl + 5 * DM};
            pg8::gemm_stream(ldsl, S, E, cx_wave);
        }
        PH_END(last && 1)

}
#undef PH_BEGIN
#undef PH_END

__global__ void __launch_bounds__(512, 2) mega(Args a) {
    Ctx cx;
    cx.ka0 = (KArgs)__builtin_amdgcn_kernarg_segment_ptr();
    cx.wave = __builtin_amdgcn_readfirstlane((int)threadIdx.x >> 6);
    { volatile LAS unsigned* bst = (volatile LAS unsigned*)((LAS unsigned char*)lds + LDS_STAGE);
      const int t0 = threadIdx.x;
      if (t0 < 2) bst[t0] = 0u;
      __syncthreads();
      xcd_barrier_post((unsigned*)(a.ws + WS_BAR), t0);
      if (a.flag < 0) cg::this_grid().sync(); }
    layer_body<0>(cx);
    layer_body<1>(cx);
}


extern "C" void kernel_launch(void* const* d_in, const int* in_sizes, int n_in, void* d_out, int out_size, void* d_ws, size_t ws_size, hipStream_t stream) {
    static int grid = 0;
    if (grid == 0) {
        if (n_in != 25 || out_size != ML * DM || ws_size < WS_END) { fprintf(stderr, "kernel_launch: unexpected shapes: n_in %d out %d ws %zu (need %zu)\n", n_in, out_size, ws_size, (size_t)WS_END); grid = -1; return; }
        int dev = 0, cus = 0, per_cu = 0;
        hipGetDevice(&dev); hipDeviceGetAttribute(&cus, hipDeviceAttributeMultiprocessorCount, dev);
        if (hipFuncSetAttribute((const void*)mega, hipFuncAttributeMaxDynamicSharedMemorySize, LDS_BYTES) != hipSuccess) { fprintf(stderr, "kernel_launch: hipFuncSetAttribute failed\n"); grid = -1; return; }
        if (hipOccupancyMaxActiveBlocksPerMultiprocessor(&per_cu, (const void*)mega, 512, LDS_BYTES) != hipSuccess || per_cu < 1) { fprintf(stderr, "kernel_launch: occupancy query gave %d\n", per_cu); per_cu = 1; }
        (void)hipGetLastError();
        grid = cus * 1;
        fprintf(stderr, "kernel_launch: cus %d per_cu %d grid %d ws %zu need %zu\n", cus, per_cu, grid, ws_size, (size_t)WS_END);
    }
    if (grid < 0) return;
    Args a{};
    for (int i = 0; i < 25; ++i) a.in[i] = (const float*)d_in[i];
    a.out = (float*)d_out; a.ws = (unsigned char*)d_ws;
    if (hipMemsetAsync((char*)d_ws + WS_BAR, 0, BAR_BYTES, stream) != hipSuccess) { fprintf(stderr, "kernel_launch: memset of barrier words failed\n"); return; }
    a.flag = 0; a.pad = 0;
    void* args[] = {&a};
    hipError_t e = hipLaunchCooperativeKernel((const void*)mega, dim3(grid), dim3(512), args, LDS_BYTES, stream);
    if (e != hipSuccess) fprintf(stderr, "kernel_launch: cooperative launch failed: %s (grid %d)\n", hipGetErrorString(e), grid);
}
```
